# Optimizing an MI355X kernel written in HIP

```python
import jax
import jax.numpy as jnp
from jax import lax
import numpy as np

D_MODEL = 2048
BATCH = 2
SEQ = 4096
DEPTH = 2

N_META = 16
CHUNK = 64
PAD = CHUNK - N_META
D_FF = 5504
FFN_RES = 0.5
EPS = 1e-6
N_BRANCH = 3
BRANCH_WIDTH = 1024

GLA_HEADS = 4
GLA_DK = 128
GLA_DV = 256
GLA_GATE_RANK = 16
GLA_GATE_TAU = 16.0

RET_HEADS = 4
RET_DK = 256
RET_DV = 256
ROPE_BASE = 10000.0

HGRN_HEADS = 8
HGRN_DK = 128
HGRN_DV = 128
FORGET_FLOOR = 1e-20

IN_SPLITS = (
    GLA_HEADS * GLA_DK, GLA_HEADS * GLA_DK, GLA_HEADS * GLA_DV, GLA_HEADS * GLA_DV, GLA_GATE_RANK,
    RET_HEADS * RET_DK, RET_HEADS * RET_DK, RET_HEADS * RET_DV, RET_HEADS * RET_DV,
    HGRN_HEADS * HGRN_DK, HGRN_HEADS * HGRN_DK, HGRN_HEADS * HGRN_DV, HGRN_HEADS * HGRN_DV,
    N_BRANCH * D_MODEL,
)
W_IN = sum(IN_SPLITS)

kernel_name = 'hybrid_gla_retnet_hgrn2_macaron_block'


def rms_norm(x, g):
    xf = x.astype(jnp.float32)
    y = xf * lax.rsqrt(jnp.mean(xf * xf, axis=-1, keepdims=True) + EPS)
    return (y * g.astype(jnp.float32)).astype(x.dtype)


def head_rms_norm(y, n_heads, g):
    b, l, w = y.shape
    yf = y.astype(jnp.float32).reshape(b, l, n_heads, w // n_heads)
    yf = yf * lax.rsqrt(jnp.mean(yf * yf, axis=-1, keepdims=True) + EPS)
    return yf.reshape(b, l, w) * g.astype(jnp.float32)


def head_group_norm(y, n_heads, g):
    b, l, w = y.shape
    yf = y.astype(jnp.float32).reshape(b, l, n_heads, w // n_heads)
    yf = yf - jnp.mean(yf, axis=-1, keepdims=True)
    yf = yf * lax.rsqrt(jnp.mean(yf * yf, axis=-1, keepdims=True) + EPS)
    return yf.reshape(b, l, w) * g.astype(jnp.float32)


def swiglu(h, w_gate, w_up, w_down):
    return (jax.nn.silu(h @ w_gate) * (h @ w_up)) @ w_down


def rotary(t, pos):
    half = t.shape[-1] // 2
    inv_freq = ROPE_BASE ** (-jnp.arange(half, dtype=jnp.float32) / half)
    ang = pos[:, None] * inv_freq[None, :]
    cos = jnp.cos(ang)[None, :, None, :]
    sin = jnp.sin(ang)[None, :, None, :]
    t1, t2 = t[..., :half], t[..., half:]
    return jnp.concatenate([t1 * cos - t2 * sin, t1 * sin + t2 * cos], axis=-1)


def to_chunks(t, n_heads):
    b, l, w = t.shape
    t = jnp.pad(t.astype(jnp.float32), ((0, 0), (PAD, 0), (0, 0)))
    t = t.reshape(b, (l + PAD) // CHUNK, CHUNK, n_heads, w // n_heads)
    return t.transpose(1, 0, 3, 2, 4)


def from_chunks(o):
    nc, b, h, c, dv = o.shape
    return o.transpose(1, 0, 3, 2, 4).reshape(b, nc * c, h * dv)[:, PAD:]


def chunk_gated_linear_attention(q, k, v, log_a):
    causal = jnp.tril(jnp.ones((CHUNK, CHUNK), dtype=bool))[:, :, None]
    nc, b, h, c, dk = q.shape
    dv = v.shape[-1]

    def step(state, inp):
        qc, kc, vc, gc = inp
        cum = jnp.cumsum(gc, axis=-2)
        diff = cum[..., :, None, :] - cum[..., None, :, :]
        decay = jnp.where(causal, jnp.exp(jnp.where(causal, diff, 0.0)), 0.0)
        scores = jnp.einsum('bhid,bhjd,bhijd->bhij', qc, kc, decay)
        o = (jnp.einsum('bhij,bhjv->bhiv', scores, vc)
             + jnp.einsum('bhid,bhdv->bhiv', qc * jnp.exp(cum), state))
        last = cum[..., -1:, :]
        state = (jnp.exp(last[..., 0, :])[..., None] * state
                 + jnp.einsum('bhjd,bhjv->bhdv', kc * jnp.exp(last - cum), vc))
        return state, o

    s0 = jnp.zeros((b, h, dk, dv), jnp.float32)
    _, o = lax.scan(step, s0, (q, k, v, log_a))
    return o


def chunk_retention(q, k, v, log_gamma):
    idx = jnp.arange(CHUNK, dtype=jnp.float32)
    rel = idx[:, None] - idx[None, :]
    causal = (rel >= 0)[None]
    intra = jnp.where(causal, jnp.exp(jnp.where(causal, rel[None], 0.0) * log_gamma[:, None, None]), 0.0)
    q_decay = jnp.exp((idx[None, :] + 1.0) * log_gamma[:, None])[..., None]
    k_decay = jnp.exp((CHUNK - 1.0 - idx[None, :]) * log_gamma[:, None])[..., None]
    chunk_decay = jnp.exp(CHUNK * log_gamma)[:, None, None]
    nc, b, h, c, dk = q.shape
    dv = v.shape[-1]

    def step(state, inp):
        qc, kc, vc = inp
        scores = jnp.einsum('bhid,bhjd->bhij', qc, kc) * intra
        o = (jnp.einsum('bhij,bhjv->bhiv', scores, vc)
             + jnp.einsum('bhid,bhdv->bhiv', qc * q_decay, state))
        state = chunk_decay * state + jnp.einsum('bhjd,bhjv->bhdv', kc * k_decay, vc)
        return state, o

    s0 = jnp.zeros((b, h, dk, dv), jnp.float32)
    _, o = lax.scan(step, s0, (q, k, v))
    return o


def hybrid_mixer(u, w_in, gla_w_gate2, gla_b_gate, gla_norm, ret_norm, hgrn_lb, hgrn_norm, w_branch, w_out):
    b, l, _ = u.shape
    f32 = jnp.float32
    split_at = [int(s) for s in np.cumsum(IN_SPLITS)[:-1]]
    (gq, gk, gv, gg, g_lr, rq, rk, rv, rg, hq, hf, hi, hg, mg) = jnp.split(u @ w_in, split_at, axis=-1)

    g_log = jax.nn.log_sigmoid((g_lr @ gla_w_gate2 + gla_b_gate).astype(f32)) / GLA_GATE_TAU
    o = chunk_gated_linear_attention(
        to_chunks(gq.astype(f32) * GLA_DK ** -0.5, GLA_HEADS), to_chunks(gk, GLA_HEADS),
        to_chunks(gv, GLA_HEADS), to_chunks(g_log, GLA_HEADS))
    y_gla = head_rms_norm(from_chunks(o), GLA_HEADS, gla_norm) * jax.nn.silu(gg.astype(f32))

    pos = jnp.arange(l, dtype=f32)
    rq = rotary(rq.astype(f32).reshape(b, l, RET_HEADS, RET_DK), pos).reshape(b, l, -1) * RET_DK ** -0.5
    rk = rotary(rk.astype(f32).reshape(b, l, RET_HEADS, RET_DK), pos).reshape(b, l, -1)
    log_gamma = jnp.log(1.0 - 2.0 ** (-5.0 - jnp.arange(RET_HEADS, dtype=f32)))
    o = chunk_retention(to_chunks(rq, RET_HEADS), to_chunks(rk, RET_HEADS), to_chunks(rv, RET_HEADS), log_gamma)
    y_ret = head_group_norm(from_chunks(o), RET_HEADS, ret_norm) * jax.nn.silu(rg.astype(f32))

    hf = hf.astype(f32)
    lb = hgrn_lb.astype(f32)
    forget = lb + (1.0 - lb) * jax.nn.sigmoid(hf)
    log_f = jnp.log(jnp.maximum(forget, FORGET_FLOOR))
    k_in = (1.0 - lb) * jax.nn.sigmoid(-hf)
    i_in = jax.nn.silu(hi.astype(f32))
    o = chunk_gated_linear_attention(
        to_chunks(hq, HGRN_HEADS), to_chunks(k_in, HGRN_HEADS),
        to_chunks(i_in, HGRN_HEADS), to_chunks(log_f, HGRN_HEADS))
    y_hgrn = head_rms_norm(from_chunks(o), HGRN_HEADS, hgrn_norm) * jax.nn.silu(hg.astype(f32))

    ys = jnp.stack([y_gla, y_ret, y_hgrn], axis=2).astype(u.dtype)
    gates = jax.nn.sigmoid(mg.astype(f32)).reshape(b, l, N_BRANCH, D_MODEL).astype(u.dtype)
    merged = (jnp.einsum('blnw,nwd->blnd', ys, w_branch) * gates).sum(axis=2)
    return merged @ w_out


def setup_inputs(seed: int = 0) -> dict:
    key = jax.random.key(seed)
    ks = jax.random.split(key, 24)
    f32 = jnp.float32

    def nrm(k, shape, scale):
        return jax.random.normal(k, shape, f32) * scale

    def gain(k, shape):
        return 1.0 + 0.02 * jax.random.normal(k, shape, f32)

    return {
        'x': nrm(ks[0], (BATCH, SEQ, D_MODEL), 1.0),
        'meta_tokens': nrm(ks[1], (N_META, D_MODEL), 1.0),
        'ffn1_norm': gain(ks[2], (DEPTH, D_MODEL)),
        'ffn1_w_gate': nrm(ks[3], (DEPTH, D_MODEL, D_FF), D_MODEL ** -0.5),
        'ffn1_w_up': nrm(ks[4], (DEPTH, D_MODEL, D_FF), D_MODEL ** -0.5),
        'ffn1_w_down': nrm(ks[5], (DEPTH, D_FF, D_MODEL), D_FF ** -0.5),
        'mix_norm': gain(ks[6], (DEPTH, D_MODEL)),
        'w_in': nrm(ks[7], (DEPTH, D_MODEL, W_IN), D_MODEL ** -0.5),
        'gla_w_gate2': nrm(ks[8], (DEPTH, GLA_GATE_RANK, GLA_HEADS * GLA_DK), GLA_GATE_RANK ** -0.5),
        'gla_b_gate': nrm(ks[9], (DEPTH, GLA_HEADS * GLA_DK), 0.1),
        'gla_norm': gain(ks[10], (DEPTH, GLA_HEADS * GLA_DV)),
        'ret_norm': gain(ks[11], (DEPTH, RET_HEADS * RET_DV)),
        'hgrn_lb_logits': nrm(ks[12], (DEPTH, HGRN_HEADS * HGRN_DK), 0.1),
        'hgrn_norm': gain(ks[13], (DEPTH, HGRN_HEADS * HGRN_DV)),
        'w_branch': nrm(ks[14], (DEPTH, N_BRANCH, BRANCH_WIDTH, D_MODEL), BRANCH_WIDTH ** -0.5),
        'w_out': nrm(ks[15], (DEPTH, D_MODEL, D_MODEL), D_MODEL ** -0.5),
        'ffn2_norm': gain(ks[16], (DEPTH, D_MODEL)),
        'ffn2_w_gate': nrm(ks[17], (DEPTH, D_MODEL, D_FF), D_MODEL ** -0.5),
        'ffn2_w_up': nrm(ks[18], (DEPTH, D_MODEL, D_FF), D_MODEL ** -0.5),
        'ffn2_w_down': nrm(ks[19], (DEPTH, D_FF, D_MODEL), D_FF ** -0.5),
        'final_norm': gain(ks[20], (D_MODEL,)),
    }


def reference(x, meta_tokens, ffn1_norm, ffn1_w_gate, ffn1_w_up, ffn1_w_down, mix_norm, w_in,
              gla_w_gate2, gla_b_gate, gla_norm, ret_norm, hgrn_lb_logits, hgrn_norm, w_branch, w_out,
              ffn2_norm, ffn2_w_gate, ffn2_w_up, ffn2_w_down, final_norm):
    b = x.shape[0]
    meta = jnp.broadcast_to(meta_tokens[None].astype(x.dtype), (b, N_META, D_MODEL))
    h = jnp.concatenate([meta, x], axis=1)
    lb_soft = jax.nn.softmax(hgrn_lb_logits.astype(jnp.float32), axis=0)
    lower_bounds = jnp.cumsum(lb_soft, axis=0) - lb_soft[0]
    for layer in range(DEPTH):
        h = h + FFN_RES * swiglu(rms_norm(h, ffn1_norm[layer]),
                                 ffn1_w_gate[layer], ffn1_w_up[layer], ffn1_w_down[layer])
        h = h + hybrid_mixer(rms_norm(h, mix_norm[layer]), w_in[layer], gla_w_gate2[layer], gla_b_gate[layer],
                             gla_norm[layer], ret_norm[layer], lower_bounds[layer], hgrn_norm[layer],
                             w_branch[layer], w_out[layer])
        h = h + FFN_RES * swiglu(rms_norm(h, ffn2_norm[layer]),
                                 ffn2_w_gate[layer], ffn2_w_up[layer], ffn2_w_down[layer])
    return rms_norm(h, final_norm)[:, N_META:]
```

```cpp
#include <hip/hip_runtime.h>
#include <hip/hip_cooperative_groups.h>
#include <cstdio>
#include <cstdint>
namespace cg = cooperative_groups;

#ifndef ONE_LAUNCH
#define ONE_LAUNCH 1
#endif
#ifndef ONLY_KIND
#define ONLY_KIND -1
#endif
#define KEN(k) (ONLY_KIND < 0 || ONLY_KIND == (k))
#ifndef REPEAT_KIND
#define REPEAT_KIND -1
#endif

#define LAS __attribute__((address_space(3)))
#define GAS __attribute__((address_space(1)))
typedef unsigned short bf16;
typedef short bf16x8 __attribute__((ext_vector_type(8)));
typedef float f32x4 __attribute__((ext_vector_type(4)));
typedef float f32x2 __attribute__((ext_vector_type(2)));
typedef unsigned u32x4 __attribute__((ext_vector_type(4)));
typedef unsigned u32x2 __attribute__((ext_vector_type(2)));
typedef __bf16 bf16x2_t __attribute__((ext_vector_type(2)));

__device__ __forceinline__ unsigned cvtpk(float lo, float hi) { f32x2 v = {lo, hi}; bf16x2_t b = __builtin_convertvector(v, bf16x2_t); return __builtin_bit_cast(unsigned, b); }
__device__ __forceinline__ unsigned short f2bf(float f) { return (unsigned short)(cvtpk(f, 0.f) & 0xffffu); }
__device__ __forceinline__ float bf2f(unsigned short v) { return __uint_as_float((unsigned)v << 16); }
__device__ __forceinline__ float bflo(unsigned w) { return __uint_as_float(w << 16); }
__device__ __forceinline__ float bfhi(unsigned w) { return __uint_as_float(w & 0xffff0000u); }
typedef unsigned long long u64;
constexpr float SSQ_SCALE = 16777216.f;
__device__ __forceinline__ float ssq_get(const u64* p, int row) { return (float)((const __attribute__((address_space(1))) u64*)p)[row] * (1.f / SSQ_SCALE); }
__device__ __forceinline__ u64 ssq_fix(float s) { return (u64)(s * SSQ_SCALE + 0.5f); }
__device__ __forceinline__ float silu_f(float x) { return x * __builtin_amdgcn_rcpf(1.f + __expf(-x)); }
__device__ __forceinline__ float sigmoid_f(float x) { return __builtin_amdgcn_rcpf(1.f + __expf(-x)); }

constexpr int D = 2048, FF = 5504, NBATCH = 2, SEQ = 4096, LP = 4160, MR = NBATCH * LP, MP = 8448, NCH = 65;
constexpr int NIN = 17664, NGU = 2 * FF;
constexpr int ZQ_G = 0, ZK_G = 512, ZV_G = 1024, ZG_G = 2048, ZQ_R = 3072, ZK_R = 4096, ZV_R = 5120, ZG_R = 6144, ZQ_H = 7168, ZF_H = 8192, ZI_H = 9216, ZG_H = 10240, ZMG = 11264, ZLR = 17408;
constexpr float EPS = 1e-6f;
constexpr int NPOS = 4112;

constexpr size_t al256(size_t x) { return (x + 255) & ~(size_t)255; }
constexpr size_t WS_SSQ = 0;
constexpr size_t WS_ROPE = al256(WS_SSQ + (size_t)7 * MP * 8);
constexpr size_t WS_LAMG = al256(WS_ROPE + (size_t)NPOS * 128 * 8);
constexpr size_t WS_LAMH = al256(WS_LAMG + (size_t)520 * 128 * 4);
constexpr size_t WS_W = al256(WS_LAMH + (size_t)1040 * 128 * 4);
constexpr size_t W_GU1 = 0, W_D1 = W_GU1 + (size_t)NGU * D * 2, W_IN = W_D1 + (size_t)D * FF * 2, W_B = W_IN + (size_t)NIN * D * 2, W_O = W_B + (size_t)3 * D * 1024 * 2,
                 W_GU2 = W_O + (size_t)D * D * 2, W_D2 = W_GU2 + (size_t)NGU * D * 2, W_END = W_D2 + (size_t)D * FF * 2;
constexpr size_t WS_H = al256(WS_W + W_END);
constexpr size_t WS_HB = al256(WS_H + (size_t)MP * D * 4);
constexpr size_t WS_Z = al256(WS_HB + (size_t)MP * D * 2);
constexpr size_t WS_QT = al256(WS_Z + (size_t)MP * NIN * 2);
constexpr size_t WS_KT = al256(WS_QT + (size_t)MR * 2560 * 2);
constexpr size_t WS_VT = al256(WS_KT + (size_t)MR * 2560 * 2);
constexpr size_t WS_P = al256(WS_VT + (size_t)MR * 3072 * 2);
constexpr size_t WS_O = al256(WS_P + (size_t)2080 * 4096 * 2);
constexpr size_t WS_MF = WS_O, WS_MB = WS_O + (size_t)MP * D * 4;
constexpr size_t WS_YS = al256(WS_O + (size_t)MP * 3072 * 4);
constexpr size_t WS_PART = al256(WS_YS + (size_t)MP * 3072 * 2);
constexpr size_t WS_CNT = al256(WS_PART + (size_t)21 * 8 * 128 * 256 * 4);
constexpr size_t WS_BAR = al256(WS_CNT + 4096);
constexpr size_t WS_O2 = al256(WS_BAR + 16384);
constexpr size_t WS_END = al256(WS_O2 + (size_t)MR * 1024 * 4);
static_assert(WS_MB + (size_t)MP * D * 2 <= WS_YS, "MF|MB alias O");
constexpr size_t QT_G = 0, QT_R = (size_t)520 * 64 * 128, QT_H = QT_R + (size_t)520 * 64 * 256;
constexpr size_t VT_G = 0, VT_R = (size_t)520 * 256 * 64, VT_H = VT_R + (size_t)520 * 256 * 64;
constexpr size_t P_G = 0, P_R = (size_t)520 * 4096, P_H = (size_t)1040 * 4096;

namespace pg8 {
constexpr int BM = 256, BK = 64, HALF = 128, HTB = HALF * BK * 2, STAGE_BYTES = 8 * HTB, NXCD = 8, WGM = 8;
__host__ __device__ __forceinline__ int lds_byte(int r, int c) { const int st = (r >> 4) * 2 + (c >> 5), rr = r & 15, cc = c & 31, ob = rr * 64 + cc * 2; return st * 1024 + (ob ^ (((ob >> 9) & 1) << 5)); }
__host__ __device__ __forceinline__ void stage_rc(int b, int& R, int& C) { const int st = b / 1024, sb = b % 1024, swz = sb ^ (((sb >> 9) & 1) << 5); R = (st >> 1) * 16 + swz / 64; C = (st & 1) * 32 + (swz % 64) / 2; }
__host__ __device__ __forceinline__ int perm32(int rho) { const int n = rho >> 4, i = rho & 15; return 8 * (i >> 2) + 4 * n + (i & 3); }

struct Unit { int pm, pn, tag, nt, rowoff, half; };
struct Gemm { const bf16* A; const bf16* Bt; int lda, ldb, K; size_t a_tag, b_tag; int b_div; size_t b_hi; };

struct StaticOrder {
    int nM, nN, nwg, G, c, reps, nt_all;
    __device__ void init(int M, int N, int G_, int c_, int reps_, int K) { nM = M / BM; nN = N / BM; nwg = nM * nN; G = G_; c = c_; reps = reps_; nt_all = K / BK; }
    __device__ void tile(int L, Unit& u) const {
        int wgid = L; { const int q = nwg / NXCD, r = nwg % NXCD, xcd = wgid % NXCD, off = wgid / NXCD; wgid = (xcd < r ? xcd * (q + 1) : r * (q + 1) + (xcd - r) * q) + off; }
        const int nig = WGM * nN, gid = wgid / nig, fm = gid * WGM, gsz = (nM - fm) < WGM ? (nM - fm) : WGM;
        u.pm = fm + ((wgid % nig) % gsz); u.pn = (wgid % nig) / gsz; u.nt = nt_all; u.rowoff = 0; u.half = 0;
    }
    __device__ bool next(int i, Unit& u) const {
        const int rep = i % reps; const long L = (long)(i / reps) * G + c; if (L >= nwg) return false;
        tile((int)L, u); u.tag = rep; return true;
    }
};
struct MainRounds {
    StaticOrder B; int nfull;
    __device__ void init(int Mmain, int N, int G_, int c_, int K) { B.init(Mmain, N, G_, c_, 1, K); nfull = (B.nwg / G_) * G_; }
    __device__ bool next(int i, Unit& u) const { const int L = i * B.G + B.c; if (L >= nfull) return false; B.tile(L, u); u.tag = 0; return true; }
};
struct TailHalves {
    StaticOrder B; int nfull, ntail, PM;
    __device__ void init(int Mmain, int N, int G_, int c_, int K) { B.init(Mmain, N, G_, c_, 1, K); nfull = (B.nwg / G_) * G_; ntail = B.nwg - nfull; PM = Mmain / BM; }
    __device__ bool next(int i, Unit& u) const {
        int j = i * B.G + B.c; u.tag = 0;
        if (j < 2 * ntail) { B.tile(nfull + (j >> 1), u); u.rowoff = (j & 1) * HALF; u.half = 1; return true; }
        j -= 2 * ntail;
        if (j < B.nN) { u.pm = PM; u.pn = j; u.nt = B.nt_all; u.rowoff = 0; u.half = 1; return true; }
        return false;
    }
};
struct SplitOrder {
    int nN, nP, nG, G, c, PM, nt_tot;
    __device__ void init(int PM_, int N, int K, int groups, int G_, int c_) { PM = PM_; nN = N / BM; nt_tot = K / BK; nP = nt_tot / 4; nG = groups; G = G_; c = c_; }
    __device__ bool next(int i, Unit& u) const {
        const int L = i * G + c; if (L >= nN * nP * nG) return false;
        u.pm = PM; u.pn = L % nN; u.tag = L / nN; const int p = u.tag % nP; u.nt = (p == nP - 1) ? nt_tot - 4 * (nP - 1) : 4; u.rowoff = 0; u.half = 0; return true;
    }
};


template <bool HALF_>
struct EpiGateUpT {
    static constexpr bool PERM = true, CHAIN = false, HALF_ONLY = HALF_;
    bf16* O; const u64* ssq;
    __device__ __forceinline__ void operator()(const f32x4 (&acc)[2][2][4][2], const Unit& u, int wr, int wc, int fr, int fq) const {
        const int row0 = u.pm * BM + u.rowoff + wr * 64 + fr, col0 = u.pn * 128 + wc * 32 + 8 * fq;
#pragma unroll
        for (int ai = 0; ai < (HALF_ ? 1 : 2); ++ai) {
#pragma unroll
            for (int m = 0; m < 4; ++m) {
                const int row = row0 + ai * HALF + m * 16; const float rs = rsqrtf(ssq_get(ssq, row) * (1.f / D) + EPS);
                float a[8];
#pragma unroll
                for (int n = 0; n < 2; ++n)
#pragma unroll
                    for (int e = 0; e < 4; ++e) { const float g = acc[ai][0][m][n][e] * rs, uu = acc[ai][1][m][n][e] * rs; a[4 * n + e] = silu_f(g) * uu; }
                u32x4 w; w.x = cvtpk(a[0], a[1]); w.y = cvtpk(a[2], a[3]); w.z = cvtpk(a[4], a[5]); w.w = cvtpk(a[6], a[7]);
                *(GAS u32x4*)(O + (size_t)row * FF + col0) = w; } }
    }
};
struct EpiRowScale {
    static constexpr bool PERM = true, CHAIN = false, HALF_ONLY = false;
    bf16* O; int ldc; const u64* ssq;
    __device__ __forceinline__ void operator()(const f32x4 (&acc)[2][2][4][2], const Unit& u, int wr, int wc, int fr, int fq) const {
        const int row0 = u.pm * BM + wr * 64 + fr, col0 = u.pn * BM + wc * 32 + 8 * fq;
#pragma unroll
        for (int ai = 0; ai < 2; ++ai)
#pragma unroll
            for (int m = 0; m < 4; ++m) {
                const int row = row0 + ai * HALF + m * 16; const float rs = rsqrtf(ssq_get(ssq, row) * (1.f / D) + EPS);
                bf16* rowp = O + (size_t)row * ldc + col0;
#pragma unroll
                for (int bj = 0; bj < 2; ++bj) { const f32x4 v0 = acc[ai][bj][m][0] * rs, v1 = acc[ai][bj][m][1] * rs;
                    u32x4 w; w.x = cvtpk(v0[0], v0[1]); w.y = cvtpk(v0[2], v0[3]); w.z = cvtpk(v1[0], v1[1]); w.w = cvtpk(v1[2], v1[3]);
                    *(GAS u32x4*)(rowp + bj * HALF) = w; } }
    }
};
struct EpiResid {
    static constexpr bool PERM = true, CHAIN = false, HALF_ONLY = false;
    float* H32; bf16* HB; u64* ssq_out; float scale;
    __device__ __forceinline__ void operator()(const f32x4 (&acc)[2][2][4][2], const Unit& u, int wr, int wc, int fr, int fq) const {
        const int row0 = u.pm * BM + wr * 64 + fr, col0 = u.pn * BM + wc * 32 + 8 * fq;
#pragma unroll
        for (int ai = 0; ai < 2; ++ai)
#pragma unroll
            for (int m = 0; m < 4; ++m) {
                const int row = row0 + ai * HALF + m * 16; const size_t off = (size_t)row * D + col0; float s = 0.f;
#pragma unroll
                for (int bj = 0; bj < 2; ++bj) { const size_t o = off + bj * HALF; const u32x4 hb = *(const GAS u32x4*)(HB + o);
                    f32x4 h0 = (f32x4){bflo(hb.x), bfhi(hb.x), bflo(hb.y), bfhi(hb.y)}, h1 = (f32x4){bflo(hb.z), bfhi(hb.z), bflo(hb.w), bfhi(hb.w)};
                    h0 = h0 + acc[ai][bj][m][0] * scale; h1 = h1 + acc[ai][bj][m][1] * scale;
                    if (H32) { *(GAS f32x4*)(H32 + o) = h0; *(GAS f32x4*)(H32 + o + 4) = h1; }
                    u32x4 w; w.x = cvtpk(h0[0], h0[1]); w.y = cvtpk(h0[2], h0[3]); w.z = cvtpk(h1[0], h1[1]); w.w = cvtpk(h1[2], h1[3]); *(GAS u32x4*)(HB + o) = w;
                    s += ((h0[0] * h0[0] + h0[1] * h0[1]) + (h0[2] * h0[2] + h0[3] * h0[3])) + ((h1[0] * h1[0] + h1[1] * h1[1]) + (h1[2] * h1[2] + h1[3] * h1[3])); }
                s += __shfl_xor(s, 16); s += __shfl_xor(s, 32);
                if (fq == 0) (void)__hip_atomic_fetch_add((GAS u64*)(ssq_out + row), ssq_fix(s), __ATOMIC_RELAXED, __HIP_MEMORY_SCOPE_AGENT); }
    }
};
struct EpiBranch {
    static constexpr bool PERM = false, CHAIN = true, HALF_ONLY = false;
    const bf16* Z; bf16* MB;
    __device__ __forceinline__ void operator()(f32x4 (&acc)[2][2][4][2], const Unit& u, int wr, int wc, int fr, int fq) const {
        const int row0 = u.pm * BM + wr * 64 + fr, col0 = u.pn * BM + wc * 32 + 4 * fq; const int n_br = u.tag;
#pragma unroll
        for (int ai = 0; ai < 2; ++ai)
#pragma unroll
            for (int m = 0; m < 4; ++m) {
                const int row = row0 + ai * HALF + m * 16; const size_t off = (size_t)row * D + col0; const bf16* zr = Z + (size_t)row * NIN + ZMG + n_br * D + col0;
#pragma unroll
                for (int bj = 0; bj < 2; ++bj)
#pragma unroll
                    for (int n = 0; n < 2; ++n) { const int co = bj * HALF + n * 16; const u32x2 gz = *(const GAS u32x2*)(zr + co);
                        const float z0[4] = {bflo(gz.x), bfhi(gz.x), bflo(gz.y), bfhi(gz.y)}; f32x4 v = acc[ai][bj][m][n];
                        if (n_br < 2) { const u32x2 gn = *(const GAS u32x2*)(zr + D + co); const float z1[4] = {bflo(gn.x), bfhi(gn.x), bflo(gn.y), bfhi(gn.y)};
#pragma unroll
                            for (int e = 0; e < 4; ++e) v[e] *= (1.f + __expf(-fminf(fmaxf(z1[e], -30.f), 30.f))) * __builtin_amdgcn_rcpf(1.f + __expf(-fminf(fmaxf(z0[e], -30.f), 30.f)));
                            acc[ai][bj][m][n] = v;
                        } else {
#pragma unroll
                            for (int e = 0; e < 4; ++e) v[e] *= __builtin_amdgcn_rcpf(1.f + __expf(-fminf(fmaxf(z0[e], -30.f), 30.f)));
                            u32x2 w; w.x = cvtpk(v[0], v[1]); w.y = cvtpk(v[2], v[3]); *(GAS u32x2*)(MB + off + co) = w; } } }
    }
};
__device__ __forceinline__ void wt_store4(float* p, f32x4 v) {
    __hip_atomic_store((u64*)p, ((u64)__float_as_uint(v[1]) << 32) | __float_as_uint(v[0]), __ATOMIC_RELAXED, __HIP_MEMORY_SCOPE_AGENT);
    __hip_atomic_store((u64*)p + 1, ((u64)__float_as_uint(v[3]) << 32) | __float_as_uint(v[2]), __ATOMIC_RELAXED, __HIP_MEMORY_SCOPE_AGENT);
}
__device__ __forceinline__ f32x4 wt_load4(const float* p) {
    const u64 a = __hip_atomic_load((const u64*)p, __ATOMIC_RELAXED, __HIP_MEMORY_SCOPE_AGENT), b = __hip_atomic_load((const u64*)p + 1, __ATOMIC_RELAXED, __HIP_MEMORY_SCOPE_AGENT);
    return (f32x4){__uint_as_float((unsigned)a), __uint_as_float((unsigned)(a >> 32)), __uint_as_float((unsigned)b), __uint_as_float((unsigned)(b >> 32))};
}
__device__ __forceinline__ void split_store(const f32x4 (&acc)[2][2][4][2], float* part, int wr, int wc, int fr, int fq) {
#pragma unroll
    for (int m = 0; m < 4; ++m)
#pragma unroll
        for (int bj = 0; bj < 2; ++bj)
#pragma unroll
            for (int n = 0; n < 2; ++n) wt_store4(part + (size_t)(wr * 64 + m * 16 + fr) * 256 + bj * HALF + wc * 32 + n * 16 + 4 * fq, acc[0][bj][m][n]);
}
struct EpiSplitStore {
    static constexpr bool PERM = false, CHAIN = false, HALF_ONLY = false;
    unsigned char* ws; int cnt_idx;
    __device__ __forceinline__ void operator()(const f32x4 (&acc)[2][2][4][2], const Unit& u, int wr, int wc, int fr, int fq) const {
        split_store(acc, (float*)(ws + WS_PART) + (size_t)(u.tag * 8 + u.pn) * 128 * 256, wr, wc, fr, fq);
        asm volatile("s_waitcnt vmcnt(0)" ::: "memory");
        __syncthreads();
        if ((wr | wc | fr | fq) == 0) __hip_atomic_fetch_add((unsigned*)(ws + WS_CNT) + cnt_idx + u.pn, 1u, __ATOMIC_RELAXED, __HIP_MEMORY_SCOPE_AGENT);
    }
};
__device__ __forceinline__ void split_wait(unsigned* cnt, unsigned total, int tid) {
    if (tid == 0) { unsigned spins = 0; while (__hip_atomic_load(cnt, __ATOMIC_RELAXED, __HIP_MEMORY_SCOPE_AGENT) < total && ++spins < (1u << 22)) __builtin_amdgcn_s_sleep(1); }
    __syncthreads();
}
__device__ __forceinline__ void split_finish_resid(unsigned char* ws, int ssq_idx, float scale, int cnt_idx, int nP, int pm, int unit, int tid, bool keep32) {
    if (unit >= 8 * nP) return;
    const int pn = unit % 8, tag = unit / 8;
    float* const H32 = (float*)(ws + WS_H); bf16* const HB = (bf16*)(ws + WS_HB); u64* const ssq_out = (u64*)(ws + WS_SSQ) + (size_t)ssq_idx * MP; const float* const PART = (const float*)(ws + WS_PART);
    split_wait((unsigned*)(ws + WS_CNT) + cnt_idx + pn, (unsigned)nP, tid);
    const int wave = tid >> 6, lane = tid & 63;
    for (int rl = tag + nP * wave; rl < 128; rl += nP * 8) {
        f32x4 a = (f32x4){0.f, 0.f, 0.f, 0.f};
        const float* pp = PART + ((size_t)pn * 128 + rl) * 256 + 4 * lane;
#pragma unroll 8
        for (int p = 0; p < nP; ++p) a = a + wt_load4(pp + (size_t)p * 8 * 128 * 256);
        const int row = pm * BM + rl; const size_t off = (size_t)row * D + pn * BM + 4 * lane;
        const u32x2 hb = *(const GAS u32x2*)(HB + off); f32x4 hv = (f32x4){bflo(hb.x), bfhi(hb.x), bflo(hb.y), bfhi(hb.y)}; hv = hv + a * scale; if (keep32) *(GAS f32x4*)(H32 + off) = hv;
        u32x2 w; w.x = cvtpk(hv[0], hv[1]); w.y = cvtpk(hv[2], hv[3]); *(GAS u32x2*)(HB + off) = w;
        float sq = (hv[0] * hv[0] + hv[1] * hv[1]) + (hv[2] * hv[2] + hv[3] * hv[3]);
#pragma unroll
        for (int o = 1; o < 64; o <<= 1) sq += __shfl_xor(sq, o);
        if (lane == 0) (void)__hip_atomic_fetch_add((GAS u64*)(ssq_out + row), ssq_fix(sq), __ATOMIC_RELAXED, __HIP_MEMORY_SCOPE_AGENT);
    }
}
__device__ __forceinline__ void split_finish_branch(unsigned char* ws, int cnt_idx, int nP, int pm, int unit, int tid) {
    const int nU = 3 * nP;
    if (unit >= 8 * nU) return;
    const int pn = unit % 8, tag = unit / 8;
    const bf16* const Z = (const bf16*)(ws + WS_Z); bf16* const MB = (bf16*)(ws + WS_MB); const float* const PART = (const float*)(ws + WS_PART);
    split_wait((unsigned*)(ws + WS_CNT) + cnt_idx + pn, (unsigned)nU, tid);
    const int wave = tid >> 6, lane = tid & 63;
    for (int rl = tag + nU * wave; rl < 128; rl += nU * 8) {
        const int row = pm * BM + rl; const size_t off = (size_t)row * D + pn * BM + 4 * lane;
        const float* pp = PART + ((size_t)pn * 128 + rl) * 256 + 4 * lane;
        f32x4 v = (f32x4){0.f, 0.f, 0.f, 0.f};
#pragma unroll
        for (int nb = 0; nb < 3; ++nb) { f32x4 a = (f32x4){0.f, 0.f, 0.f, 0.f};
            for (int p = 0; p < nP; ++p) a = a + wt_load4(pp + (size_t)(nb * nP + p) * 8 * 128 * 256);
            const u32x2 gz = *(const u32x2*)(Z + (size_t)row * NIN + ZMG + nb * D + pn * BM + 4 * lane);
            v[0] += a[0] * sigmoid_f(bflo(gz.x)); v[1] += a[1] * sigmoid_f(bfhi(gz.x)); v[2] += a[2] * sigmoid_f(bflo(gz.y)); v[3] += a[3] * sigmoid_f(bfhi(gz.y)); }
        u32x2 w; w.x = cvtpk(v[0], v[1]); w.y = cvtpk(v[2], v[3]); *(u32x2*)(MB + off) = w;
    }
}

template <class Epi, class Sched>
__device__ __forceinline__ void gemm_phase(LAS unsigned char* lds, const Gemm g, const Sched& S, const Epi& E, const int tid) {
    const int wid = __builtin_amdgcn_readfirstlane(tid >> 6), lane = tid & 63, wr = wid >> 2, wc = wid & 3, fr = lane & 15, fq = lane >> 4;
    unsigned voffA[2], voffB[2];
#pragma unroll
    for (int i = 0; i < 2; ++i) { int R, C; stage_rc(tid * 16 + i * 8192, R, C); const int Rb = Epi::PERM ? ((R & ~31) + perm32(R & 31)) : R;
        voffA[i] = (unsigned)(R * g.lda + C) * 2u; voffB[i] = (unsigned)(Rb * g.ldb + C) * 2u; }
    const size_t kstep = (size_t)(BK * 2);
    const size_t hstepA = (size_t)HALF * g.lda * 2, hstepB = (size_t)HALF * g.ldb * 2;
    const size_t tstepA = 2 * hstepA, tstepB = 2 * hstepB;
    const unsigned ldsw = (unsigned)wid * 1024u;
    const int aoff = lds_byte(wr * 64 + fr, fq * 8), boff = lds_byte(wc * 32 + fr, fq * 8);
#define PG8_SA(b, h) (((b) * 2 + (h)) * HTB)
#define PG8_SB(b, h) ((4 + (b) * 2 + (h)) * HTB)
#define PG8_STAGE(bufoff, gbase, voff) do { _Pragma("unroll") for (int _i = 0; _i < 2; ++_i) \
        __builtin_amdgcn_global_load_lds((const unsigned*)((const char*)(gbase) + (voff)[_i]), (LAS unsigned*)(lds + (bufoff) + ldsw + _i * 8192), 16, 0, 0); } while (0)
#define PG8_LDA(dst, b, h) do { _Pragma("unroll") for (int m = 0; m < 4; ++m) _Pragma("unroll") for (int k = 0; k < 2; ++k) dst[m][k] = *(const LAS bf16x8*)(lds + PG8_SA(b, h) + aoff + m * 2048 + k * 1024); } while (0)
#define PG8_LDB(dst, b, h) do { _Pragma("unroll") for (int n = 0; n < 2; ++n) _Pragma("unroll") for (int k = 0; k < 2; ++k) dst[n][k] = *(const LAS bf16x8*)(lds + PG8_SB(b, h) + boff + n * 2048 + k * 1024); } while (0)
#define PG8_MMA(ai, bj, At, Bt) do { __builtin_amdgcn_s_setprio(1); _Pragma("unroll") for (int m = 0; m < 4; ++m) _Pragma("unroll") for (int n = 0; n < 2; ++n) _Pragma("unroll") for (int k = 0; k < 2; ++k) \
        acc[ai][bj][m][n] = __builtin_amdgcn_mfma_f32_16x16x32_bf16(Bt[n][k], At[m][k], acc[ai][bj][m][n], 0, 0, 0); __builtin_amdgcn_s_setprio(0); } while (0)
#define PG8_WAIT_V(n) asm volatile("s_waitcnt vmcnt(" #n ")" ::: "memory")
#define PG8_WAIT_L(n) asm volatile("s_waitcnt lgkmcnt(" #n ")" ::: "memory")
#define PG8_BAR __builtin_amdgcn_s_barrier()
#define PG8_SCHED __builtin_amdgcn_sched_barrier(0)
    Unit cur, nxt; int ui = 0;
    if (!S.next(0, cur)) return;
    float z0 = 0.f; asm volatile("" : "+v"(z0));
    f32x4 acc[2][2][4][2];
#pragma unroll
    for (int a = 0; a < 2; ++a)
#pragma unroll
        for (int b = 0; b < 2; ++b)
#pragma unroll
            for (int m = 0; m < 4; ++m)
#pragma unroll
                for (int n = 0; n < 2; ++n) acc[a][b][m][n] = (f32x4){z0, z0, z0, z0};
    bf16x8 At[4][2], B0[2][2], B1[2][2];
    const char* cA = (const char*)g.A + (size_t)cur.pm * tstepA + (size_t)cur.rowoff * g.lda * 2 + (size_t)cur.tag * g.a_tag; const char* cB = (const char*)g.Bt + (size_t)cur.pn * tstepB + (size_t)(cur.tag % g.b_div) * g.b_tag + (size_t)(cur.tag / g.b_div) * g.b_hi;
    PG8_STAGE(PG8_SB(0, 0), cB, voffB); PG8_STAGE(PG8_SB(0, 1), cB + hstepB, voffB); PG8_STAGE(PG8_SA(0, 0), cA, voffA); PG8_STAGE(PG8_SA(0, 1), cA + hstepA, voffA);
    if (wr == 1) PG8_BAR;
    PG8_WAIT_V(2); PG8_BAR;
    PG8_STAGE(PG8_SB(1, 0), cB + kstep, voffB); PG8_STAGE(PG8_SA(1, 0), cA + kstep, voffA); PG8_STAGE(PG8_SB(1, 1), cB + hstepB + kstep, voffB);
    PG8_WAIT_V(6); PG8_BAR;
    for (;;) {
        const bool has_next = S.next(ui + 1, nxt);
        const char* nA = has_next ? (const char*)g.A + (size_t)nxt.pm * tstepA + (size_t)nxt.rowoff * g.lda * 2 + (size_t)nxt.tag * g.a_tag : cA;
        const char* nB = has_next ? (const char*)g.Bt + (size_t)nxt.pn * tstepB + (size_t)(nxt.tag % g.b_div) * g.b_tag + (size_t)(nxt.tag / g.b_div) * g.b_hi : cB;
        const int nt = cur.nt;
        for (int t = 0; t < nt; t += 2) {
            const bool last = (t == nt - 2);
            const char* a1 = cA + (size_t)(t + 1) * kstep;
            const char* a2 = last ? nA : cA + (size_t)(t + 2) * kstep; const char* b2 = last ? nB : cB + (size_t)(t + 2) * kstep;
            const char* a3 = a2 + kstep; const char* b3 = b2 + kstep;
            PG8_LDB(B0, 0, 0); PG8_LDB(B1, 0, 1); PG8_SCHED; PG8_LDA(At, 0, 0); PG8_STAGE(PG8_SA(1, 1), a1 + hstepA, voffA);
            PG8_WAIT_V(8); PG8_WAIT_L(0); PG8_BAR; PG8_MMA(0, 0, At, B0); PG8_MMA(0, 1, At, B1); PG8_BAR; PG8_SCHED;
            PG8_LDA(At, 0, 1); PG8_STAGE(PG8_SB(0, 0), b2, voffB); PG8_STAGE(PG8_SB(0, 1), b2 + hstepB, voffB); PG8_STAGE(PG8_SA(0, 0), a2, voffA);
            PG8_WAIT_V(8); PG8_WAIT_L(0); PG8_BAR; if constexpr (!Epi::HALF_ONLY) { PG8_MMA(1, 0, At, B0); PG8_MMA(1, 1, At, B1); } PG8_BAR; PG8_SCHED;
            PG8_LDB(B0, 1, 0); PG8_LDB(B1, 1, 1); PG8_SCHED; PG8_LDA(At, 1, 0); PG8_STAGE(PG8_SA(0, 1), a2 + hstepA, voffA);
            PG8_WAIT_V(8); PG8_WAIT_L(0); PG8_BAR; PG8_MMA(0, 0, At, B0); PG8_MMA(0, 1, At, B1); PG8_BAR; PG8_SCHED;
            PG8_LDA(At, 1, 1); PG8_STAGE(PG8_SB(1, 0), b3, voffB); PG8_STAGE(PG8_SB(1, 1), b3 + hstepB, voffB); PG8_STAGE(PG8_SA(1, 0), a3, voffA);
            PG8_WAIT_V(8); PG8_WAIT_L(0); PG8_BAR; if constexpr (!Epi::HALF_ONLY) { PG8_MMA(1, 0, At, B0); PG8_MMA(1, 1, At, B1); } PG8_BAR; PG8_SCHED;
        }
        if (wr == 0) PG8_BAR;
        E(acc, cur, wr, wc, fr, fq);
        if (!has_next) break;
        if (!Epi::CHAIN || cur.tag == 2) {
#pragma unroll
        for (int a = 0; a < 2; ++a)
#pragma unroll
            for (int b = 0; b < 2; ++b)
#pragma unroll
                for (int m = 0; m < 4; ++m)
#pragma unroll
                    for (int n = 0; n < 2; ++n) acc[a][b][m][n] = (f32x4){z0, z0, z0, z0};
        }
        cur = nxt; cA = nA; cB = nB; ++ui;
        if (wr == 1) PG8_BAR;
    }
    PG8_WAIT_V(0);
    PG8_BAR;
#undef PG8_SA
#undef PG8_SB
#undef PG8_STAGE
#undef PG8_LDA
#undef PG8_LDB
#undef PG8_MMA
#undef PG8_WAIT_V
#undef PG8_WAIT_L
#undef PG8_BAR
#undef PG8_SCHED
}
}

constexpr int LDS_BYTES = 147456;
constexpr int NPHASE = 22;

struct Args { const float* in[21]; float* out; unsigned char* ws; int ph_lo, ph_hi; };

struct Frame {
    LAS unsigned char* lds;
    int tid, lane, wave, vcu, G, bid;
    const float* const* in;
    unsigned char* ws;
};

__device__ __forceinline__ float wave_sum(float v) {
#pragma unroll
    for (int o = 1; o < 64; o <<= 1) v += __shfl_xor(v, o);
    return v;
}

__device__ __forceinline__ void conv_item(const float* W, int ldw, int col0, int nvalid, const float* gain, float scale, bf16* dst, int K, int k0, LAS float* scr, int lane) {
    const int n4 = (lane & 15) * 4, kq = lane >> 4;
    const float* wp = W + (size_t)(k0 + kq) * ldw + col0 + n4; const size_t wstep = (size_t)4 * ldw;
    f32x4 v[16];
#pragma unroll
    for (int i = 0; i < 16; ++i) { v[i] = (f32x4){0.f, 0.f, 0.f, 0.f}; if (n4 < nvalid) v[i] = *(const GAS f32x4*)(wp + (size_t)i * wstep); }
#pragma unroll
    for (int i = 0; i < 16; ++i) { const int kk = 4 * i + kq; const float g = (gain ? gain[k0 + kk] : 1.f) * scale; LAS float* sp = scr + kk * 65 + n4;
        sp[0] = v[i][0] * g; sp[1] = v[i][1] * g; sp[2] = v[i][2] * g; sp[3] = v[i][3] * g; }
    asm volatile("s_waitcnt lgkmcnt(0)" ::: "memory");
    const int c = lane & 7;
#pragma unroll
    for (int j = 0; j < 8; ++j) { const int n = (lane >> 3) + 8 * j; const LAS float* s = scr + (8 * c) * 65 + n;
        u32x4 o; o.x = cvtpk(s[0 * 65], s[1 * 65]); o.y = cvtpk(s[2 * 65], s[3 * 65]); o.z = cvtpk(s[4 * 65], s[5 * 65]); o.w = cvtpk(s[6 * 65], s[7 * 65]);
        *(GAS u32x4*)(dst + (size_t)n * K + 8 * c) = o; }
    asm volatile("s_waitcnt lgkmcnt(0)" ::: "memory");
}

constexpr int CI_GU = (NGU / 64) * (D / 64), CI_D = (D / 64) * (FF / 64), CI_IN = (NIN / 64) * (D / 64), CI_B = 3 * (D / 64) * (1024 / 64), CI_O = (D / 64) * (D / 64);
constexpr int CI_PARTA = CI_GU + CI_D + CI_IN, CI_ALL = CI_PARTA + CI_B + CI_O + CI_GU + CI_D;
__device__ __forceinline__ void convert_range(Frame& F, int L, int lo, int hi, int gw, int NGW) {
    LAS float* scr = (LAS float*)(F.lds + F.wave * 16640);
    unsigned char* wb = F.ws + WS_W;
    for (int it = lo + gw; it < hi; it += NGW) {
        int r = it, f = 0;
        if (r >= CI_PARTA + CI_B + CI_O) { f = 1; r -= CI_PARTA + CI_B + CI_O; }
        const float* W; const float* gain = nullptr; bf16* dst; int ldw, col0, nvalid = 64, K, kb; float sc = 1.f;
        if (r < CI_GU) {
            const int nb = r % (NGU / 64); kb = r / (NGU / 64);
            const int j = nb >> 2, half = (nb >> 1) & 1, sub = nb & 1;
            W = (half ? F.in[f ? 18 : 4] : F.in[f ? 17 : 3]) + (size_t)L * D * FF; gain = F.in[f ? 16 : 2] + (size_t)L * D; ldw = FF; col0 = j * 128 + sub * 64; K = D;
            dst = (bf16*)(wb + (f ? W_GU2 : W_GU1)) + (size_t)(nb * 64) * D;
        } else if (r < CI_GU + CI_D) { r -= CI_GU;
            const int nb = r % (D / 64); kb = r / (D / 64);
            W = F.in[f ? 19 : 5] + (size_t)L * FF * D; ldw = D; col0 = nb * 64; K = FF;
            dst = (bf16*)(wb + (f ? W_D2 : W_D1)) + (size_t)(nb * 64) * FF;
        } else if (r < CI_PARTA) { r -= CI_GU + CI_D;
            const int nb = r % (NIN / 64); kb = r / (NIN / 64); const int n0 = nb * 64;
            if (n0 < 3072) col0 = n0; else if (n0 < ZLR) col0 = n0 + 16; else if (n0 == ZLR) { col0 = 3072; nvalid = 16; } else { col0 = 0; nvalid = 0; }
            if (n0 < 512) sc = 0.08838834764831845f;
            else if (n0 >= ZQ_R && n0 < ZK_R) sc = 0.0625f;
            W = F.in[7] + (size_t)L * D * 17424; gain = F.in[6] + (size_t)L * D; ldw = 17424; K = D;
            dst = (bf16*)(wb + W_IN) + (size_t)n0 * D;
        } else if (r < CI_PARTA + CI_B) { r -= CI_PARTA;
            const int n = r / (CI_B / 3); r -= n * (CI_B / 3); const int nb = r % (D / 64); kb = r / (D / 64);
            W = F.in[14] + ((size_t)L * 3 + n) * 1024 * D; ldw = D; col0 = nb * 64; K = 1024;
            dst = (bf16*)(wb + W_B) + ((size_t)n * D + nb * 64) * 1024;
        } else { r -= CI_PARTA + CI_B;
            const int nb = r % (D / 64); kb = r / (D / 64);
            W = F.in[15] + (size_t)L * D * D; ldw = D; col0 = nb * 64; K = D;
            dst = (bf16*)(wb + W_O) + (size_t)(nb * 64) * D; }
        conv_item(W, ldw, col0, nvalid, gain, sc, dst + kb * 64, K, kb * 64, scr, F.lane);
    }
}

__device__ __forceinline__ void init_phase(Frame& F) {
    const int gw = F.vcu * 8 + F.wave, NGW = F.G * 8;
    float* H = (float*)(F.ws + WS_H); bf16* HB = (bf16*)(F.ws + WS_HB); u64* ssq = (u64*)(F.ws + WS_SSQ);
    for (int r = gw; r < MP; r += NGW) {
        const float* src = nullptr;
        if (r < MR) { const int b = r / LP, p = r % LP; if (p >= 64) src = F.in[0] + ((size_t)b * SEQ + (p - 64)) * D; else if (p >= 48) src = F.in[1] + (size_t)(p - 48) * D; }
        f32x4 v[8]; float s = 0.f;
#pragma unroll
        for (int j = 0; j < 8; ++j) { v[j] = src ? ((const GAS f32x4*)src)[F.lane + 64 * j] : (f32x4){0.f, 0.f, 0.f, 0.f}; s += (v[j][0] * v[j][0] + v[j][1] * v[j][1]) + (v[j][2] * v[j][2] + v[j][3] * v[j][3]); }
        s = wave_sum(s);
#pragma unroll
        for (int j = 0; j < 8; ++j) { u32x2 w; w.x = cvtpk(v[j][0], v[j][1]); w.y = cvtpk(v[j][2], v[j][3]); ((GAS u32x2*)(HB + (size_t)r * D))[F.lane + 64 * j] = w; }
        if (F.lane == 0) ((GAS u64*)ssq)[r] = ssq_fix(s);
    }
    const int gt = F.vcu * 512 + F.tid, NT = F.G * 512;
    for (int i = gt; i < 6 * MP; i += NT) ssq[MP + i] = 0ull;
    if (gt < 1024) ((unsigned*)(F.ws + WS_CNT))[gt] = 0u;
    float* rope = (float*)(F.ws + WS_ROPE);
    for (int i = gt; i < NPOS * 128; i += NT) { const int pos = i >> 7, k = i & 127;
        const float inv = exp2f(-(float)k * (13.287712379549449f / 128.f)); const float ang = (float)pos * inv;
        const double rev = (double)ang * 0.15915494309189535; const float fr = (float)(rev - __builtin_rint(rev));
        rope[2 * i] = __builtin_amdgcn_cosf(fr); rope[2 * i + 1] = __builtin_amdgcn_sinf(fr); }
}

template <int DV>
__device__ __forceinline__ void write_vT(int tid, const bf16* Zv  , bf16* VTci, bool do_silu) {
#pragma unroll
    for (int n = 0; n < DV / 128; ++n) { const int idx = tid + 512 * n, e = idx % DV, jb = idx / DV; unsigned w[8];
#pragma unroll
        for (int jj = 0; jj < 8; ++jj) { unsigned short v0 = Zv[(size_t)(16 * jb + 2 * jj) * NIN + e], v1 = Zv[(size_t)(16 * jb + 2 * jj + 1) * NIN + e];
            if (do_silu) w[jj] = cvtpk(silu_f(bf2f(v0)), silu_f(bf2f(v1))); else w[jj] = (unsigned)v0 | ((unsigned)v1 << 16); }
        GAS u32x4* dst = (GAS u32x4*)(VTci + (size_t)e * 64 + 16 * jb); dst[0] = (u32x4){w[0], w[1], w[2], w[3]}; dst[1] = (u32x4){w[4], w[5], w[6], w[7]}; }
}

template <int NC>
__device__ __forceinline__ void stage_tile(LAS unsigned char* dst, const bf16* src, int tid) {
#pragma unroll
    for (int n = 0; n < (64 * NC / 8) / 512; ++n) { const int idx = tid + 512 * n, row = idx / (NC / 8), cp = idx % (NC / 8);
        *(LAS u32x4*)(dst + row * (NC * 2) + cp * 16) = *(const GAS u32x4*)(src + (size_t)row * NIN + cp * 8); }
}
template <int DV>
__device__ __forceinline__ void write_vT_lds(int tid, const LAS unsigned short* vs, bf16* VTci, bool do_silu) {
#pragma unroll
    for (int n = 0; n < DV / 128; ++n) { const int idx = tid + 512 * n, e = idx % DV, jb = idx / DV; unsigned w[8];
#pragma unroll
        for (int jj = 0; jj < 8; ++jj) { const unsigned short v0 = vs[(16 * jb + 2 * jj) * DV + e], v1 = vs[(16 * jb + 2 * jj + 1) * DV + e];
            if (do_silu) w[jj] = cvtpk(silu_f(bf2f(v0)), silu_f(bf2f(v1))); else w[jj] = (unsigned)v0 | ((unsigned)v1 << 16); }
        GAS u32x4* dst = (GAS u32x4*)(VTci + (size_t)e * 64 + 16 * jb); dst[0] = (u32x4){w[0], w[1], w[2], w[3]}; dst[1] = (u32x4){w[4], w[5], w[6], w[7]}; }
}

constexpr int PR_W2S = 0, PR_BS = 8192, PR_GLR = 8704, PR_TOT = 12800, PR_QH = 14848, PR_HB = 32 * 272, PR_KH = PR_QH + 3 * PR_HB, PR_END = PR_KH + 3 * PR_HB, PR_RAWQ = PR_END, PR_RAWK = PR_RAWQ + 16384, PR_RAWV = PR_RAWK + 16384;
template <int BR>
__device__ __forceinline__ void prep_gh(Frame& F, int L, int item) {
    constexpr int H = BR == 0 ? 4 : 8, DV = BR == 0 ? 256 : 128;
    const int h = item % H, bc = item / H, c = bc % NCH, b = bc / NCH, rowb = b * LP + c * 64, ci = item;
    LAS float* w2s = (LAS float*)(F.lds + PR_W2S); LAS float* bs = (LAS float*)(F.lds + PR_BS); LAS float* glr = (LAS float*)(F.lds + PR_GLR); LAS float* tot = (LAS float*)(F.lds + PR_TOT);
    int t_ = F.tid; asm volatile("" : "+v"(t_));
    const int t = t_, d = t & 127, i0 = t >> 7;
    const bf16* Z = (const bf16*)(F.ws + WS_Z) + (size_t)rowb * NIN;
    float lbv = 0.f;
    stage_tile<128>(F.lds + PR_RAWQ, Z + (BR == 0 ? ZQ_G : ZQ_H) + h * 128, t);
    stage_tile<128>(F.lds + PR_RAWK, Z + (BR == 0 ? ZK_G : ZF_H) + h * 128, t);
    stage_tile<DV>(F.lds + PR_RAWV, Z + (BR == 0 ? ZV_G : ZI_H) + h * DV, t);
    if (BR == 0) {
        const float* w2 = F.in[8] + (size_t)L * 16 * 512; const float* bg = F.in[9] + (size_t)L * 512;
        for (int idx = t; idx < 2048; idx += 512) w2s[idx] = ((const GAS float*)w2)[(idx >> 7) * 512 + h * 128 + (idx & 127)];
        if (t < 128) bs[t] = ((const GAS float*)bg)[h * 128 + t];
        for (int idx = t; idx < 1024; idx += 512) glr[idx] = bf2f(((const GAS bf16*)Z)[(size_t)(idx >> 4) * NIN + ZLR + (idx & 15)]);
    } else if (L == 1) {
        const float l0 = F.in[12][h * 128 + d], l1 = F.in[12][1024 + h * 128 + d]; const float mx = fmaxf(l0, l1), e0 = __expf(l0 - mx), e1 = __expf(l1 - mx); lbv = e1 / (e0 + e1);
    }
    __syncthreads();
    float qv[16], kv[16], cv[16]; float run = 0.f;
    unsigned short rawq[16], rawk[16];
#pragma unroll
    for (int ii = 0; ii < 16; ++ii) { rawq[ii] = ((const LAS unsigned short*)(F.lds + PR_RAWQ))[(16 * i0 + ii) * 128 + d]; rawk[ii] = ((const LAS unsigned short*)(F.lds + PR_RAWK))[(16 * i0 + ii) * 128 + d]; }
#pragma unroll
    for (int ii = 0; ii < 16; ++ii) { const int i = 16 * i0 + ii; float q = bf2f(rawq[ii]), k, gl;
        if (BR == 0) { k = bf2f(rawk[ii]); float x = bs[d];
#pragma unroll
            for (int j = 0; j < 16; ++j) x += glr[i * 16 + j] * w2s[j * 128 + d];
            gl = (fminf(x, 0.f) - __logf(1.f + __expf(-fabsf(x)))) * (1.f / 16.f);
        } else { const float hf = bf2f(rawk[ii]); const float e = __expf(fminf(-hf, 80.f)), sg = __builtin_amdgcn_rcpf(1.f + e);
            gl = __logf(fmaxf(lbv + (1.f - lbv) * sg, 1e-20f)); k = (1.f - lbv) * e * sg; }
        run += gl; qv[ii] = q; kv[ii] = k; cv[ii] = run;
        if ((ii & 3) == 3) __builtin_amdgcn_sched_barrier(0); }
    tot[i0 * 128 + d] = run;
    __syncthreads();
    const float t0 = tot[d], t1 = tot[128 + d], t2 = tot[256 + d], t3 = tot[384 + d];
    const float r15 = t0, r31 = t0 + t1, r47 = r31 + t2, last = r47 + t3;
    const float off = i0 == 0 ? 0.f : (i0 == 1 ? r15 : (i0 == 2 ? r31 : r47));
#pragma unroll
    for (int ii = 0; ii < 16; ++ii) cv[ii] += off;
    bf16* QT = (bf16*)(F.ws + WS_QT) + (BR == 0 ? QT_G : QT_H) + (size_t)ci * 64 * 128;
    bf16* KT = (bf16*)(F.ws + WS_KT) + (BR == 0 ? QT_G : QT_H) + (size_t)ci * 128 * 64;
    bf16* Pm = (bf16*)(F.ws + WS_P) + (BR == 0 ? P_G : P_H) + (size_t)ci * 4096;
    float* LAM = (float*)(F.ws + (BR == 0 ? WS_LAMG : WS_LAMH)) + (size_t)ci * 128;
#pragma unroll
    for (int ii = 0; ii < 16; ++ii) ((GAS bf16*)QT)[(16 * i0 + ii) * 128 + d] = f2bf(qv[ii] * __expf(cv[ii]));
    if (i0 == 0) ((GAS float*)LAM)[d] = __expf(last);
    { unsigned w[8];
#pragma unroll
      for (int jj = 0; jj < 8; ++jj) w[jj] = cvtpk(kv[2 * jj] * __expf(last - cv[2 * jj]), kv[2 * jj + 1] * __expf(last - cv[2 * jj + 1]));
      GAS u32x4* dst = (GAS u32x4*)(KT + (size_t)d * 64 + 16 * i0); dst[0] = (u32x4){w[0], w[1], w[2], w[3]}; dst[1] = (u32x4){w[4], w[5], w[6], w[7]}; }
    {
        LAS unsigned short* QH = (LAS unsigned short*)(F.lds + PR_QH); LAS unsigned short* KH = (LAS unsigned short*)(F.lds + PR_KH);
        const int il = (16 * i0) & 31;
        if (i0 < 2) {
#pragma unroll
            for (int ii = 0; ii < 16; ++ii) { const int o = (il + ii) * 136 + d;
                QH[o] = f2bf(qv[ii] * __expf(fminf(cv[ii] - r15, 80.f))); KH[o] = f2bf(kv[ii] * __expf(fminf(r15 - cv[ii], 80.f))); KH[(PR_HB / 2) + o] = f2bf(kv[ii] * __expf(r31 - cv[ii])); }
        } else {
#pragma unroll
            for (int ii = 0; ii < 16; ++ii) { const int o = (il + ii) * 136 + d;
                QH[(PR_HB / 2) + o] = f2bf(qv[ii] * __expf(cv[ii] - r31)); QH[2 * (PR_HB / 2) + o] = f2bf(qv[ii] * __expf(fminf(cv[ii] - r47, 80.f))); KH[2 * (PR_HB / 2) + o] = f2bf(kv[ii] * __expf(fminf(r47 - cv[ii], 80.f))); }
        }
    }
    __syncthreads();
    { const int w = F.wave, r = F.lane & 15, q = F.lane >> 4;
#pragma unroll
      for (int tt = 0; tt < 2; ++tt) { const int T = w + 8 * tt, ti = T >> 2, tj = T & 3, I = ti >> 1, J = tj >> 1; f32x4 acc = (f32x4){0.f, 0.f, 0.f, 0.f};
          if (J <= I) { const int blk = I == 0 ? 0 : (J == 0 ? 1 : 2);
              const LAS unsigned char* qa = F.lds + PR_QH + blk * PR_HB + (16 * (ti & 1) + r) * 272 + 16 * q; const LAS unsigned char* kb = F.lds + PR_KH + blk * PR_HB + (16 * (tj & 1) + r) * 272 + 16 * q;
#pragma unroll
              for (int k = 0; k < 4; ++k) acc = __builtin_amdgcn_mfma_f32_16x16x32_bf16(*(const LAS bf16x8*)(kb + 64 * k), *(const LAS bf16x8*)(qa + 64 * k), acc, 0, 0, 0); }
          const int i = 16 * ti + r, j0 = 16 * tj + 4 * q;
          u32x2 pw; pw.x = cvtpk(j0 <= i ? acc[0] : 0.f, j0 + 1 <= i ? acc[1] : 0.f); pw.y = cvtpk(j0 + 2 <= i ? acc[2] : 0.f, j0 + 3 <= i ? acc[3] : 0.f);
          *(GAS u32x2*)(Pm + i * 64 + j0) = pw; } }
    write_vT_lds<DV>(t, (const LAS unsigned short*)(F.lds + PR_RAWV), (bf16*)(F.ws + WS_VT) + (BR == 0 ? VT_G : VT_H) + (size_t)ci * DV * 64, BR == 2);
    __syncthreads();
}

constexpr int RR_Q = 0, RR_K = 64 * 528, RR_RAWQ = 2 * 64 * 528, RR_RAWK = RR_RAWQ + 32768;
__device__ __forceinline__ void prep_ret(Frame& F, int item) {
    const int h = item % 4, bc = item / 4, c = bc % NCH, b = bc / NCH, rowb = b * LP + c * 64, ci = item;
    LAS unsigned short* QR = (LAS unsigned short*)(F.lds + RR_Q); LAS unsigned short* KR = (LAS unsigned short*)(F.lds + RR_K);
    int t_ = F.tid; asm volatile("" : "+v"(t_));
    const int t = t_, d = t & 127, i0 = t >> 7;
    const bf16* Z = (const bf16*)(F.ws + WS_Z) + (size_t)rowb * NIN;
    const float* rope = (const float*)(F.ws + WS_ROPE);
    const float lg = logf(1.f - exp2f(-5.f - (float)h));
    bf16* QT = (bf16*)(F.ws + WS_QT) + QT_R + (size_t)ci * 64 * 256;
    bf16* KT = (bf16*)(F.ws + WS_KT) + QT_R + (size_t)ci * 256 * 64;
    bf16* Pm = (bf16*)(F.ws + WS_P) + P_R + (size_t)ci * 4096;
    stage_tile<256>(F.lds + RR_RAWQ, Z + ZQ_R + h * 256, t);
    stage_tile<256>(F.lds + RR_RAWK, Z + ZK_R + h * 256, t);
    __syncthreads();
    float k0v[16], k1v[16];
#pragma unroll
    for (int hf = 0; hf < 4; ++hf) {
        unsigned short r1[4], r2[4], r3[4], r4[4]; f32x2 rc[4];
#pragma unroll
        for (int i8 = 0; i8 < 4; ++i8) { const int i = 16 * i0 + 4 * hf + i8; int pos = c * 64 + i - 48; pos = pos < 0 ? 0 : pos;
            const LAS unsigned short* rq_ = (const LAS unsigned short*)(F.lds + RR_RAWQ) + i * 256 + d; const LAS unsigned short* rk_ = (const LAS unsigned short*)(F.lds + RR_RAWK) + i * 256 + d;
            rc[i8] = *(const GAS f32x2*)(rope + ((size_t)pos * 128 + d) * 2); r1[i8] = rq_[0]; r2[i8] = rq_[128]; r3[i8] = rk_[0]; r4[i8] = rk_[128]; }
        __builtin_amdgcn_sched_barrier(0);
#pragma unroll
        for (int i8 = 0; i8 < 4; ++i8) { const int ii = 4 * hf + i8, i = 16 * i0 + ii; const f32x2 csn = rc[i8];
            const float q1 = bf2f(r1[i8]), q2 = bf2f(r2[i8]), k1 = bf2f(r3[i8]), k2 = bf2f(r4[i8]);
            const float rq0 = q1 * csn.x - q2 * csn.y, rq1 = q1 * csn.y + q2 * csn.x, rk0 = k1 * csn.x - k2 * csn.y, rk1 = k1 * csn.y + k2 * csn.x;
            QR[i * 264 + d] = f2bf(rq0); QR[i * 264 + 128 + d] = f2bf(rq1); KR[i * 264 + d] = f2bf(rk0); KR[i * 264 + 128 + d] = f2bf(rk1);
            const float gq = __expf((float)(i + 1) * lg), gk = __expf((float)(63 - i) * lg);
            ((GAS bf16*)QT)[i * 256 + d] = f2bf(rq0 * gq); ((GAS bf16*)QT)[i * 256 + 128 + d] = f2bf(rq1 * gq); k0v[ii] = rk0 * gk; k1v[ii] = rk1 * gk; }
        __builtin_amdgcn_sched_barrier(0);
    }
    { unsigned w0[8], w1[8];
#pragma unroll
      for (int jj = 0; jj < 8; ++jj) { w0[jj] = cvtpk(k0v[2 * jj], k0v[2 * jj + 1]); w1[jj] = cvtpk(k1v[2 * jj], k1v[2 * jj + 1]); }
      GAS u32x4* dst = (GAS u32x4*)(KT + (size_t)d * 64 + 16 * i0); dst[0] = (u32x4){w0[0], w0[1], w0[2], w0[3]}; dst[1] = (u32x4){w0[4], w0[5], w0[6], w0[7]};
      dst = (GAS u32x4*)(KT + (size_t)(d + 128) * 64 + 16 * i0); dst[0] = (u32x4){w1[0], w1[1], w1[2], w1[3]}; dst[1] = (u32x4){w1[4], w1[5], w1[6], w1[7]}; }
    __syncthreads();
    stage_tile<256>(F.lds + RR_RAWQ, Z + ZV_R + h * 256, t);
    { const int w = F.wave, r = F.lane & 15, q = F.lane >> 4;
#pragma unroll
      for (int tt = 0; tt < 2; ++tt) { const int T = w + 8 * tt, ti = T >> 2, tj = T & 3; f32x4 acc = (f32x4){0.f, 0.f, 0.f, 0.f};
          if (tj <= ti) { const LAS unsigned char* qa = F.lds + RR_Q + (16 * ti + r) * 528 + 16 * q; const LAS unsigned char* kb = F.lds + RR_K + (16 * tj + r) * 528 + 16 * q;
#pragma unroll
              for (int k = 0; k < 8; ++k) acc = __builtin_amdgcn_mfma_f32_16x16x32_bf16(*(const LAS bf16x8*)(kb + 64 * k), *(const LAS bf16x8*)(qa + 64 * k), acc, 0, 0, 0); }
          const int i = 16 * ti + r, j0 = 16 * tj + 4 * q; float pv[4];
#pragma unroll
          for (int jj = 0; jj < 4; ++jj) pv[jj] = (j0 + jj <= i) ? acc[jj] * __expf((float)(i - j0 - jj) * lg) : 0.f;
          u32x2 pw; pw.x = cvtpk(pv[0], pv[1]); pw.y = cvtpk(pv[2], pv[3]);
          *(GAS u32x2*)(Pm + i * 64 + j0) = pw; } }
    __syncthreads();
    write_vT_lds<256>(t, (const LAS unsigned short*)(F.lds + RR_RAWQ), (bf16*)(F.ws + WS_VT) + VT_R + (size_t)ci * 256 * 64, false);
    __syncthreads();
}

template <bool CONSTLAM, bool USEP>
__device__ __forceinline__ void scan_item(Frame& F, const bf16* QT, int QLD, size_t qci, const bf16* KT, size_t kci, const bf16* VT, size_t vci, const bf16* Pm, const float* LAM, float lamc,
                                          bf16* O, int OLD, int ocol, int H, int h, int b) {
    constexpr int DK = 128, QS = DK * 2 + 16, RS = 144;
    constexpr int OFF_Q = 0, OFF_K = OFF_Q + 64 * QS, OFF_V = OFF_K + DK * RS, OFF_P = OFF_V + 128 * RS, OFF_L = OFF_P + 64 * RS;
    LAS unsigned char* lds = F.lds;
    const int t = F.tid, w = F.wave, r = F.lane & 15, q = F.lane >> 4;
    float zs = 0.f; asm volatile("" : "+v"(zs));
    f32x4 S[DK / 16];
#pragma unroll
    for (int i = 0; i < DK / 16; ++i) S[i] = (f32x4){zs, zs, zs, zs};
    f32x4 rlA = (f32x4){zs, zs, zs, zs}, rlB = rlA; u32x4 rqA[2], rkA[2], rvA[2], rqB[2], rkB[2], rvB[2], rpA = __builtin_bit_cast(u32x4, rlA), rpB = rpA;
    const unsigned qob0 = (unsigned)((t >> 4) * QLD + (t & 15) * 8) * 2u, qob1 = (unsigned)(((t + 512) >> 4) * QLD + (t & 15) * 8) * 2u, lob = (unsigned)t * 16u;
#define SCAN_LOAD(cc, rq, rk, rv, rp, rl) do { \
        const size_t ci_ = (size_t)(b * NCH + (cc)) * H + h; \
        const char* gq_ = (const char*)(QT + ci_ * qci); const char* gk_ = (const char*)(KT + ci_ * kci); const char* gv_ = (const char*)(VT + ci_ * vci); \
        rq[0] = *(const GAS u32x4*)(gq_ + qob0); rq[1] = *(const GAS u32x4*)(gq_ + qob1); \
        rk[0] = *(const GAS u32x4*)(gk_ + lob); rk[1] = *(const GAS u32x4*)(gk_ + lob + 8192u); \
        rv[0] = *(const GAS u32x4*)(gv_ + lob); rv[1] = *(const GAS u32x4*)(gv_ + lob + 8192u); \
        if (USEP) rp = *(const GAS u32x4*)((const char*)(Pm + ci_ * 4096) + lob); \
        if (!CONSTLAM) { if (t < DK / 4) rl = *(const GAS f32x4*)((const char*)(LAM + ci_ * DK) + lob); } \
    } while (0)
#define SCAN_PUT(base, rq, rk, rv, rp, rl) do { \
        _Pragma("unroll") for (int i_ = 0; i_ < 2; ++i_) { const int idx_ = t + 512 * i_; \
            *(LAS u32x4*)((base) + OFF_Q + (idx_ >> 4) * QS + (idx_ & 15) * 16) = rq[i_]; \
            *(LAS u32x4*)((base) + OFF_K + (idx_ >> 3) * RS + (idx_ & 7) * 16) = rk[i_]; \
            *(LAS u32x4*)((base) + OFF_V + (idx_ >> 3) * RS + (idx_ & 7) * 16) = rv[i_]; } \
        if (USEP) *(LAS u32x4*)((base) + OFF_P + (t >> 3) * RS + (t & 7) * 16) = rp; \
        if (!CONSTLAM) { if (t < DK / 4) *(LAS f32x4*)((base) + OFF_L + t * 16) = rl; } \
    } while (0)
    constexpr int BUFB = 65536;
    SCAN_LOAD(0, rqA, rkA, rvA, rpA, rlA);
    SCAN_LOAD(1, rqB, rkB, rvB, rpB, rlB);
    SCAN_PUT(lds, rqA, rkA, rvA, rpA, rlA);
    SCAN_LOAD(2, rqA, rkA, rvA, rpA, rlA);
    __syncthreads();
    for (int c2 = 0; c2 < NCH; c2 += 2) {
#pragma unroll
      for (int ph_ = 0; ph_ < 2; ++ph_) {
        const int c = c2 + ph_;
        if (c < NCH) {
        LAS unsigned char* const ldc = lds + ph_ * BUFB;
        bf16x8 vf[2];
#pragma unroll
        for (int jt = 0; jt < 2; ++jt) vf[jt] = *(const LAS bf16x8*)(ldc + OFF_V + (16 * w + r) * RS + (32 * jt + 8 * q) * 2);
        f32x4 o[4];
#pragma unroll
        for (int it = 0; it < 4; ++it) o[it] = (f32x4){0.f, 0.f, 0.f, 0.f};
#pragma unroll
        for (int kb = 0; kb < 2; ++kb) {
            u32x2 qlo[2][4], qhi[2][4];
#pragma unroll
            for (int k2 = 0; k2 < 2; ++k2)
#pragma unroll
                for (int it = 0; it < 4; ++it) { const int k = 2 * kb + k2; qlo[k2][it] = *(const LAS u32x2*)(ldc + OFF_Q + (16 * it + r) * QS + (32 * k + 4 * q) * 2); qhi[k2][it] = *(const LAS u32x2*)(ldc + OFF_Q + (16 * it + r) * QS + (32 * k + 16 + 4 * q) * 2); }
            bf16x8 sf[2];
#pragma unroll
            for (int k2 = 0; k2 < 2; ++k2) { const int k = 2 * kb + k2; u32x4 p; p.x = cvtpk(S[2 * k][0], S[2 * k][1]); p.y = cvtpk(S[2 * k][2], S[2 * k][3]); p.z = cvtpk(S[2 * k + 1][0], S[2 * k + 1][1]); p.w = cvtpk(S[2 * k + 1][2], S[2 * k + 1][3]); sf[k2] = __builtin_bit_cast(bf16x8, p); }
            __builtin_amdgcn_sched_barrier(0); __builtin_amdgcn_s_setprio(1);
#pragma unroll
            for (int k2 = 0; k2 < 2; ++k2)
#pragma unroll
                for (int it = 0; it < 4; ++it) o[it] = __builtin_amdgcn_mfma_f32_16x16x32_bf16(sf[k2], __builtin_bit_cast(bf16x8, ((u32x4){qlo[k2][it].x, qlo[k2][it].y, qhi[k2][it].x, qhi[k2][it].y})), o[it], 0, 0, 0);
            __builtin_amdgcn_s_setprio(0); __builtin_amdgcn_sched_barrier(0);
        }
        bf16* orow = O + (size_t)(b * LP + c * 64 + r) * OLD + ocol + 16 * w + 4 * q;
        if (USEP) {
            bf16x8 pf[4][2];
#pragma unroll
            for (int it = 0; it < 4; ++it)
#pragma unroll
                for (int jt = 0; jt < 2; ++jt) pf[it][jt] = *(const LAS bf16x8*)(ldc + OFF_P + (16 * it + r) * RS + (32 * jt + 8 * q) * 2);
            __builtin_amdgcn_sched_barrier(0);
#pragma unroll
            for (int jt = 0; jt < 2; ++jt)
#pragma unroll
                for (int it = 0; it < 4; ++it) o[it] = __builtin_amdgcn_mfma_f32_16x16x32_bf16(vf[jt], pf[it][jt], o[it], 0, 0, 0);
        }
#pragma unroll
        for (int it = 0; it < 4; ++it) { u32x2 pw; pw.x = cvtpk(o[it][0], o[it][1]); pw.y = cvtpk(o[it][2], o[it][3]); *(GAS u32x2*)(orow + (size_t)(16 * it) * OLD) = pw; }
        __builtin_amdgcn_sched_barrier(0);
#pragma unroll
        for (int hb = 0; hb < 2; ++hb) {
            bf16x8 kf[4][2];
#pragma unroll
            for (int d4 = 0; d4 < 4; ++d4)
#pragma unroll
                for (int jt = 0; jt < 2; ++jt) kf[d4][jt] = *(const LAS bf16x8*)(ldc + OFF_K + (16 * (4 * hb + d4) + r) * RS + (32 * jt + 8 * q) * 2);
            f32x4 lam[4];
#pragma unroll
            for (int d4 = 0; d4 < 4; ++d4) { if (CONSTLAM) lam[d4] = (f32x4){lamc, lamc, lamc, lamc}; else lam[d4] = *(const LAS f32x4*)(ldc + OFF_L + (16 * (4 * hb + d4) + 4 * q) * 4); }
            __builtin_amdgcn_sched_barrier(0); __builtin_amdgcn_s_setprio(1);
#pragma unroll
            for (int d4 = 0; d4 < 4; ++d4) S[4 * hb + d4] = S[4 * hb + d4] * lam[d4];
#pragma unroll
            for (int jt = 0; jt < 2; ++jt)
#pragma unroll
                for (int d4 = 0; d4 < 4; ++d4) S[4 * hb + d4] = __builtin_amdgcn_mfma_f32_16x16x32_bf16(kf[d4][jt], vf[jt], S[4 * hb + d4], 0, 0, 0);
            __builtin_amdgcn_s_setprio(0); __builtin_amdgcn_sched_barrier(0);
        }
        if (c + 1 < NCH) {
            if (ph_ == 0) { SCAN_PUT(lds + BUFB, rqB, rkB, rvB, rpB, rlB); if (c + 3 < NCH) SCAN_LOAD(c + 3, rqB, rkB, rvB, rpB, rlB); }
            else { SCAN_PUT(lds, rqA, rkA, rvA, rpA, rlA); if (c + 3 < NCH) SCAN_LOAD(c + 3, rqA, rkA, rvA, rpA, rlA); }
        }
        __syncthreads();
        }
      }
    }
#undef SCAN_PUT
#undef SCAN_LOAD
}

constexpr int N_SCAN_ITEMS = 64;
__device__ __forceinline__ void scan_phase(Frame& F, int L) {
    const bf16* QT = (const bf16*)(F.ws + WS_QT); const bf16* KT = (const bf16*)(F.ws + WS_KT); const bf16* VT = (const bf16*)(F.ws + WS_VT); const bf16* Pm = (const bf16*)(F.ws + WS_P);
    bf16* O = (bf16*)(F.ws + WS_O); bf16* O2 = (bf16*)(F.ws + WS_O2);
    if (F.G > N_SCAN_ITEMS && F.bid >= N_SCAN_ITEMS) {
        const int gw = (F.bid - N_SCAN_ITEMS) * 8 + F.wave, NGW = (F.G - N_SCAN_ITEMS) * 8;
        for (int j = 0; j < (L == 0 ? 2 : 1); ++j) convert_range(F, j == 0 ? L : 1, j == 0 ? CI_PARTA : 0, j == 0 ? CI_ALL : CI_PARTA, gw, NGW);
        return;
    }
    for (int item = F.bid; item < N_SCAN_ITEMS; item += F.G) {
        if (item < 16) { const int es = item & 1, h = (item >> 1) & 3, b = item >> 3;
            scan_item<false, true>(F, QT + QT_G, 128, 64 * 128, KT + QT_G, 128 * 64, VT + VT_G + (size_t)es * 128 * 64, 256 * 64, Pm + P_G, (const float*)(F.ws + WS_LAMG), 0.f, O, 3072, 0 + h * 256 + es * 128, 4, h, b);
        } else if (item < 48) { const int it = item - 16, dh = it & 1, es = (it >> 1) & 1, h = (it >> 2) & 3, b = it >> 4;
            const float lamc = __expf(64.f * logf(1.f - exp2f(-5.f - (float)h)));
            if (dh == 0) scan_item<true, true>(F, QT + QT_R, 256, 64 * 256, KT + QT_R, 256 * 64, VT + VT_R + (size_t)es * 128 * 64, 256 * 64, Pm + P_R, nullptr, lamc, O, 3072, 1024 + h * 256 + es * 128, 4, h, b);
            else scan_item<true, false>(F, QT + QT_R + 128, 256, 64 * 256, KT + QT_R + (size_t)128 * 64, 256 * 64, VT + VT_R + (size_t)es * 128 * 64, 256 * 64, Pm + P_R, nullptr, lamc, O2, 1024, h * 256 + es * 128, 4, h, b);
        } else { const int it = item - 48, h = it & 7, b = it >> 3;
            scan_item<false, true>(F, QT + QT_H, 128, 64 * 128, KT + QT_H, 128 * 64, VT + VT_H, 128 * 64, Pm + P_H, (const float*)(F.ws + WS_LAMH), 0.f, O, 3072, 2048 + h * 128, 8, h, b);
        }
    }
}

__device__ __forceinline__ void normgate_phase(Frame& F, int L) {
    const int gw = F.vcu * 8 + F.wave, NGW = F.G * 8, lane = F.lane;
    const bf16* O = (const bf16*)(F.ws + WS_O); const bf16* O2 = (const bf16*)(F.ws + WS_O2); const bf16* Z = (const bf16*)(F.ws + WS_Z); bf16* YS = (bf16*)(F.ws + WS_YS);
    for (int r = gw; r < MR; r += NGW) {
#pragma unroll
        for (int br = 0; br < 3; ++br) {
            const float* gain = F.in[br == 0 ? 10 : (br == 1 ? 11 : 13)] + (size_t)L * 1024;
            const int zg = br == 0 ? ZG_G : (br == 1 ? ZG_R : ZG_H);
#pragma unroll
            for (int hh = 0; hh < 4; ++hh) { const int col = hh * 256 + 4 * lane;
                const u32x2 pa = *(const GAS u32x2*)(O + (size_t)r * 3072 + br * 1024 + col);
                f32x4 v = (f32x4){bflo(pa.x), bfhi(pa.x), bflo(pa.y), bfhi(pa.y)};
                if (br == 1) { const u32x2 pb = *(const GAS u32x2*)(O2 + (size_t)r * 1024 + col); v = v + (f32x4){bflo(pb.x), bfhi(pb.x), bflo(pb.y), bfhi(pb.y)}; }
                if (br == 1) { const float mean = wave_sum((v[0] + v[1]) + (v[2] + v[3])) * (1.f / 256.f); v = v - mean; }
                float ss = (v[0] * v[0] + v[1] * v[1]) + (v[2] * v[2] + v[3] * v[3]);
                if (br == 2) {
#pragma unroll
                    for (int o = 1; o < 32; o <<= 1) ss += __shfl_xor(ss, o);
                    ss *= (1.f / 128.f);
                } else ss = wave_sum(ss) * (1.f / 256.f);
                const float rs = rsqrtf(ss + EPS);
                const f32x4 gn = *(const GAS f32x4*)(gain + col); const u32x2 gz = *(const GAS u32x2*)(Z + (size_t)r * NIN + zg + col);
                const float y0 = v[0] * rs * gn[0] * silu_f(bflo(gz.x)), y1 = v[1] * rs * gn[1] * silu_f(bfhi(gz.x)), y2 = v[2] * rs * gn[2] * silu_f(bflo(gz.y)), y3 = v[3] * rs * gn[3] * silu_f(bfhi(gz.y));
                u32x2 w; w.x = cvtpk(y0, y1); w.y = cvtpk(y2, y3); *(GAS u32x2*)(YS + (size_t)r * 3072 + br * 1024 + col) = w; }
        }
    }
}

__device__ __forceinline__ void final_phase(Frame& F, float* out) {
    const int gw = F.vcu * 8 + F.wave, NGW = F.G * 8, lane = F.lane;
    const float* H = (const float*)(F.ws + WS_H); const u64* ssq = (const u64*)(F.ws + WS_SSQ) + (size_t)6 * MP; const float* gain = F.in[20];
    for (int o = gw; o < NBATCH * SEQ; o += NGW) { const int b = o / SEQ, s = o % SEQ, r = b * LP + 64 + s; const float rs = rsqrtf(ssq_get(ssq, r) * (1.f / D) + EPS);
#pragma unroll
        for (int j = 0; j < 8; ++j) { const f32x4 v = ((const GAS f32x4*)(H + (size_t)r * D))[lane + 64 * j], gn = ((const GAS f32x4*)gain)[lane + 64 * j]; ((GAS f32x4*)(out + (size_t)o * D))[lane + 64 * j] = v * rs * gn; } }
}

#define XB_TMO      128
#define XB_XCNT(j)  (256  + 64 * (j))
#define XB_XSUB(j)  (1280 + 64 * (j))
#define XB_XGEN(j)  (2304 + 64 * (j))
#define XB_TOP      3328
#define XB_TOPGEN   3392
#define XCD_BAR_WORDS 3456
#define XB_SPIN_CAP (1u << 18)

__device__ __forceinline__ unsigned xb_ld(unsigned* p)              { return __hip_atomic_load(p, __ATOMIC_RELAXED, __HIP_MEMORY_SCOPE_AGENT); }
__device__ __forceinline__ unsigned xb_add(unsigned* p, unsigned v) { return __hip_atomic_fetch_add(p, v, __ATOMIC_RELAXED, __HIP_MEMORY_SCOPE_AGENT); }
__device__ __forceinline__ unsigned xb_xcc_id() { return (unsigned)__builtin_amdgcn_s_getreg((3 << 11) | 20) & 0xFu; }
#define XB_SPIN(cond, bar) do { unsigned _sp = 0; while (cond) { __builtin_amdgcn_s_sleep(1); \
    if ((++_sp & 255u) == 0u) { if (xb_ld(&(bar)[XB_TMO])) break; if (_sp > XB_SPIN_CAP) { atomicAdd(&(bar)[XB_TMO], 1u); break; } } } } while (0)

struct XcdBarrier {
    unsigned* bar; unsigned x;
    volatile LAS unsigned* st;
};

__device__ __forceinline__ XcdBarrier xcd_barrier_post(unsigned* bar, volatile LAS unsigned* st) {
    XcdBarrier b; b.bar = bar; b.x = xb_xcc_id(); b.st = st;
    if (threadIdx.x == 0) (void)xb_add(&bar[XB_XCNT(b.x)], 1u);
    return b;
}
__device__ __forceinline__ void xcd_barrier_complete(unsigned* bar, unsigned x, unsigned& nloc, unsigned& nx) {
    const unsigned G = gridDim.x * gridDim.y * gridDim.z;
    unsigned sum, cnt, mine, sp = 0u;
    for (;;) {
        sum = 0u; cnt = 0u; mine = 0u;
#pragma unroll
        for (unsigned j = 0; j < 16; ++j) { const unsigned c = xb_ld(&bar[XB_XCNT(j)]); sum += c; cnt += (c > 0u) ? 1u : 0u; mine = (j == x) ? c : mine; }
        if (sum == G) break;
        __builtin_amdgcn_s_sleep(1);
        if ((++sp & 255u) == 0u) { if (xb_ld(&bar[XB_TMO])) break; if (sp > XB_SPIN_CAP) { atomicAdd(&bar[XB_TMO], 1u); break; } }
    }
    nloc = mine > 0u ? mine : 1u; nx = cnt > 0u ? cnt : 1u;
}

__device__ __forceinline__ void xcd_barrier(const XcdBarrier& b) {
    asm volatile("s_waitcnt vmcnt(0)" ::: "memory");
    __syncthreads();
    if (threadIdx.x == 0) {
        unsigned* bar = b.bar;
        __builtin_amdgcn_s_waitcnt(0);
        unsigned nloc = b.st[0], nx = b.st[1];
        if (nloc == 0u) { xcd_barrier_complete(bar, b.x, nloc, nx); b.st[0] = nloc; b.st[1] = nx; }
        const unsigned old = xb_add(&bar[XB_XSUB(b.x)], 1u);
        const unsigned gen = old / nloc;
        if (old + 1u == (gen + 1u) * nloc) {
            __builtin_amdgcn_fence(__ATOMIC_RELEASE, "agent");
            asm volatile("s_waitcnt vmcnt(0)" ::: "memory");
            const unsigned og = xb_add(&bar[XB_TOP], 1u);
            const unsigned tg = og / nx;
            if (og + 1u == (tg + 1u) * nx) xb_add(&bar[XB_TOPGEN], 1u);
            else XB_SPIN(xb_ld(&bar[XB_TOPGEN]) == tg, bar);
            __builtin_amdgcn_fence(__ATOMIC_ACQUIRE, "agent");
            xb_add(&bar[XB_XGEN(b.x)], 1u);
            asm volatile("s_waitcnt vmcnt(0)" ::: "memory");
        } else {
            XB_SPIN(xb_ld(&bar[XB_XGEN(b.x)]) == gen, bar);
            __builtin_amdgcn_fence(__ATOMIC_ACQUIRE, "agent");
            asm volatile("s_waitcnt vmcnt(0)" ::: "memory");
        }
    }
    __syncthreads();
}


__global__ void __launch_bounds__(512, 2) trunk_fwd(Args args) {
    extern __shared__ __attribute__((aligned(16))) unsigned char lds_raw[];
    Frame F;
    F.lds = (LAS unsigned char*)lds_raw;
    if (threadIdx.x == 0) { volatile LAS unsigned* st_ = (volatile LAS unsigned*)((LAS unsigned char*)lds_raw + 147328); st_[0] = 0u; st_[1] = 0u; }
    if (args.ph_hi - args.ph_lo > 1) {
        if (blockIdx.x == 0) { for (int i_ = threadIdx.x; i_ < XCD_BAR_WORDS; i_ += 512) ((unsigned*)(args.ws + WS_BAR))[i_] = 0u; }
        __syncthreads(); cg::this_grid().sync();
        (void)xcd_barrier_post((unsigned*)(args.ws + WS_BAR), (volatile LAS unsigned*)((LAS unsigned char*)lds_raw + 147328));
    }
#if REPEAT_KIND >= 0
    for (int ph2 = 2 * args.ph_lo; ph2 < 2 * args.ph_hi; ++ph2) {
        const int ph = ph2 >> 1;
        { int k_ = ph == 0 ? 0 : (ph <= 10 ? ph : (ph <= 20 ? ph - 10 : 12));
          const bool rpt = (k_ == REPEAT_KIND) || (REPEAT_KIND == 1 && k_ == 9) || (REPEAT_KIND == 0 && k_ == 11);
          if ((ph2 & 1) && !rpt) continue; }
#else
    for (int ph = args.ph_lo; ph < args.ph_hi; ++ph) {
#endif
        unsigned char* ws = args.ws; asm volatile("" : "+s"(ws));
        int tid_ = threadIdx.x; asm volatile("" : "+v"(tid_));
        int bid = blockIdx.x; asm volatile("" : "+s"(bid));
        int G_ = gridDim.x; asm volatile("" : "+s"(G_)); F.G = G_;
        int zero_ = 0; asm volatile("" : "+s"(zero_)); F.in = args.in + zero_;
        F.ws = ws; F.tid = tid_; F.lane = tid_ & 63; F.wave = __builtin_amdgcn_readfirstlane(tid_ >> 6); F.bid = bid;
        F.vcu = (F.G % 8 == 0) ? (bid % 8) * (F.G / 8) + bid / 8 : bid;
        u64* ssq = (u64*)(ws + WS_SSQ);
        bf16* HB = (bf16*)(ws + WS_HB); float* Hf = (float*)(ws + WS_H); bf16* Zb = (bf16*)(ws + WS_Z); bf16* ACT = Zb;
        int L = 0, kind;
        if (ph == 0) kind = 0; else if (ph <= 10) kind = ph; else if (ph <= 20) { kind = ph - 10; L = 1; } else kind = 12;
        if (kind == 0) { if (KEN(0)) { init_phase(F); convert_range(F, 0, 0, CI_PARTA, F.vcu * 8 + F.wave, F.G * 8); } }
        else if (KEN(1) && (kind == 1 || kind == 9)) {
            pg8::Gemm g{HB, (const bf16*)(ws + WS_W + (kind == 1 ? W_GU1 : W_GU2)), D, D, D, 0, 0, 1, 0}; { pg8::MainRounds S; S.init(8192, NGU, F.G, F.bid, D);
              pg8::EpiGateUpT<false> E{ACT, ssq + (size_t)(3 * L + (kind == 1 ? 0 : 2)) * MP};
              pg8::gemm_phase<pg8::EpiGateUpT<false>, pg8::MainRounds>(F.lds, g, S, E, F.tid); }
            { pg8::TailHalves S; S.init(8192, NGU, F.G, F.bid, D);
              pg8::EpiGateUpT<true> E{ACT, ssq + (size_t)(3 * L + (kind == 1 ? 0 : 2)) * MP};
              pg8::gemm_phase<pg8::EpiGateUpT<true>, pg8::TailHalves>(F.lds, g, S, E, F.tid); }
        } else if (KEN(2) && (kind == 2 || kind == 10)) {
            const bf16* Wd = (const bf16*)(ws + WS_W + (kind == 2 ? W_D1 : W_D2)); const int si = 3 * L + (kind == 2 ? 1 : 3);
            { pg8::Gemm g{ACT, Wd, FF, FF, FF, 512, 512, 1 << 30, 0}; pg8::SplitOrder S; S.init(32, D, FF, 1, F.G, F.bid);
              pg8::EpiSplitStore E{ws, ph * 8};
              pg8::gemm_phase<pg8::EpiSplitStore, pg8::SplitOrder>(F.lds, g, S, E, F.tid); }
            { pg8::Gemm g{ACT, Wd, FF, FF, FF, 0, 0, 1, 0}; pg8::StaticOrder S; S.init(8192, D, F.G, F.bid, 1, FF);
              pg8::EpiResid E{(L == 1 && kind == 10) ? Hf : nullptr, HB, ssq + (size_t)si * MP, 0.5f};
              pg8::gemm_phase<pg8::EpiResid, pg8::StaticOrder>(F.lds, g, S, E, F.tid); }
            pg8::split_finish_resid(ws, si, 0.5f, ph * 8, FF / 256, 32, F.bid, F.tid, L == 1 && kind == 10);
        } else if (KEN(3) && kind == 3) {
            pg8::Gemm g{HB, (const bf16*)(ws + WS_W + W_IN), D, D, D, 0, 0, 1, 0}; pg8::StaticOrder S; S.init(MP, NIN, F.G, F.bid, 1, D);
            pg8::EpiRowScale E{Zb, NIN, ssq + (size_t)(3 * L + 1) * MP};
            pg8::gemm_phase<pg8::EpiRowScale, pg8::StaticOrder>(F.lds, g, S, E, F.tid);
        } else if (KEN(4) && kind == 4) {
            for (int it = F.bid; it < 2080; it += F.G) { if (it < 520) prep_gh<0>(F, L, it); else if (it < 1040) prep_ret(F, it - 520); else prep_gh<2>(F, L, it - 1040); }
        } else if (KEN(5) && kind == 5) { scan_phase(F, L); }
        else if (KEN(6) && kind == 6) { normgate_phase(F, L); }
        else if (KEN(7) && kind == 7) {
            { pg8::Gemm g{(const bf16*)(ws + WS_YS), (const bf16*)(ws + WS_W + W_B), 3072, 1024, 1024, 512, 512, 4, (size_t)D * 1024 * 2}; pg8::SplitOrder S; S.init(32, D, 1024, 3, F.G, F.bid);
              pg8::EpiSplitStore E{ws, ph * 8};
              pg8::gemm_phase<pg8::EpiSplitStore, pg8::SplitOrder>(F.lds, g, S, E, F.tid); }
            { pg8::Gemm g{(const bf16*)(ws + WS_YS), (const bf16*)(ws + WS_W + W_B), 3072, 1024, 1024, (size_t)1024 * 2, 0, 1, (size_t)D * 1024 * 2}; pg8::StaticOrder S; S.init(8192, D, F.G, F.bid, 3, 1024);
              pg8::EpiBranch E{Zb, (bf16*)(ws + WS_MB)};
              pg8::gemm_phase<pg8::EpiBranch, pg8::StaticOrder>(F.lds, g, S, E, F.tid); }
            pg8::split_finish_branch(ws, ph * 8, 4, 32, F.bid, F.tid);
        } else if (KEN(8) && kind == 8) {
            { pg8::Gemm g{(const bf16*)(ws + WS_MB), (const bf16*)(ws + WS_W + W_O), D, D, D, 512, 512, 1 << 30, 0}; pg8::SplitOrder S; S.init(32, D, D, 1, F.G, F.bid);
              pg8::EpiSplitStore E{ws, ph * 8};
              pg8::gemm_phase<pg8::EpiSplitStore, pg8::SplitOrder>(F.lds, g, S, E, F.tid); }
            { pg8::Gemm g{(const bf16*)(ws + WS_MB), (const bf16*)(ws + WS_W + W_O), D, D, D, 0, 0, 1, 0}; pg8::StaticOrder S; S.init(8192, D, F.G, F.bid, 1, D);
              pg8::EpiResid E{nullptr, HB, ssq + (size_t)(3 * L + 2) * MP, 1.0f};
              pg8::gemm_phase<pg8::EpiResid, pg8::StaticOrder>(F.lds, g, S, E, F.tid); }
            pg8::split_finish_resid(ws, 3 * L + 2, 1.0f, ph * 8, D / 256, 32, F.bid, F.tid, false);
        } else if (KEN(12) && kind == 12) { final_phase(F, args.out); }
        if (ph + 1 < args.ph_hi) {
            volatile LAS unsigned* st_ = (volatile LAS unsigned*)((LAS unsigned char*)lds_raw + 147328);
            { XcdBarrier xb_; xb_.bar = (unsigned*)(ws + WS_BAR); xb_.x = xb_xcc_id(); xb_.st = st_; xcd_barrier(xb_); }
        }
    }
}

extern "C" void kernel_launch(void* const* d_in, const int* in_sizes, int n_in, void* d_out, int out_size, void* d_ws, size_t ws_size, hipStream_t stream) {
    static int grid = 0;
    if (grid == 0) {
        if (n_in != 21 || out_size != NBATCH * SEQ * D || ws_size < WS_END) { fprintf(stderr, "kernel_launch: unexpected shapes (n_in %d out %d ws %zu need %zu)\n", n_in, out_size, ws_size, (size_t)WS_END); grid = -1; return; }
        int dev = 0, cus = 0;
        if (hipGetDevice(&dev) != hipSuccess || hipDeviceGetAttribute(&cus, hipDeviceAttributeMultiprocessorCount, dev) != hipSuccess) { grid = -1; return; }
        if (hipFuncSetAttribute((const void*)trunk_fwd, hipFuncAttributeMaxDynamicSharedMemorySize, LDS_BYTES) != hipSuccess) { fprintf(stderr, "kernel_launch: hipFuncSetAttribute failed\n"); grid = -1; return; }
        int per_cu = 0;
        if (hipOccupancyMaxActiveBlocksPerMultiprocessor(&per_cu, (const void*)trunk_fwd, 512, LDS_BYTES) != hipSuccess || per_cu < 1) { fprintf(stderr, "kernel_launch: occupancy query says %d\n", per_cu); }
        (void)hipGetLastError();
        grid = cus;
    }
    if (grid < 0) return;
    Args a{};
    for (int i = 0; i < 21; ++i) a.in[i] = (const float*)d_in[i];
    a.out = (float*)d_out; a.ws = (unsigned char*)d_ws;
#if ONE_LAUNCH
    a.ph_lo = 0; a.ph_hi = NPHASE;
    void* kargs[] = {&a};
    hipError_t e = hipLaunchCooperativeKernel((const void*)trunk_fwd, dim3(grid), dim3(512), kargs, LDS_BYTES, stream);
    if (e != hipSuccess) fprintf(stderr, "cooperative launch failed: %s (grid %d)\n", hipGetErrorString(e), grid);
#else
    for (int ph = 0; ph < NPHASE; ++ph) { a.ph_lo = ph; a.ph_hi = ph + 1; hipLaunchKernelGGL(trunk_fwd, dim3(grid), dim3(512), LDS_BYTES, stream, a); }
#endif
}
```

```cpp
#include <hip/hip_runtime.h>
#include <hip/hip_cooperative_groups.h>
#include <cstdio>
#include <cstdint>
namespace cg = cooperative_groups;

#ifndef ONE_LAUNCH
#define ONE_LAUNCH 1
#endif
#ifndef ONLY_KIND
#define ONLY_KIND -1
#endif
#define KEN(k) (ONLY_KIND < 0 || ONLY_KIND == (k))
#ifndef REPEAT_KIND
#define REPEAT_KIND -1
#endif

#define LAS __attribute__((address_space(3)))
#define GAS __attribute__((address_space(1)))
typedef unsigned short bf16;
typedef short bf16x8 __attribute__((ext_vector_type(8)));
typedef float f32x4 __attribute__((ext_vector_type(4)));
typedef float f32x2 __attribute__((ext_vector_type(2)));
typedef unsigned u32x4 __attribute__((ext_vector_type(4)));
typedef unsigned u32x2 __attribute__((ext_vector_type(2)));
typedef __bf16 bf16x2_t __attribute__((ext_vector_type(2)));

__device__ __forceinline__ unsigned cvtpk(float lo, float hi) { f32x2 v = {lo, hi}; bf16x2_t b = __builtin_convertvector(v, bf16x2_t); return __builtin_bit_cast(unsigned, b); }
__device__ __forceinline__ unsigned short f2bf(float f) { return (unsigned short)(cvtpk(f, 0.f) & 0xffffu); }
__device__ __forceinline__ float bf2f(unsigned short v) { return __uint_as_float((unsigned)v << 16); }
__device__ __forceinline__ float bflo(unsigned w) { return __uint_as_float(w << 16); }
__device__ __forceinline__ float bfhi(unsigned w) { return __uint_as_float(w & 0xffff0000u); }
typedef unsigned long long u64;
constexpr float SSQ_SCALE = 16777216.f;
__device__ __forceinline__ float ssq_get(const u64* p, int row) { return (float)p[row] * (1.f / SSQ_SCALE); }
__device__ __forceinline__ u64 ssq_fix(float s) { return (u64)(s * SSQ_SCALE + 0.5f); }
__device__ __forceinline__ float silu_f(float x) { return x * __builtin_amdgcn_rcpf(1.f + __expf(-x)); }
__device__ __forceinline__ float sigmoid_f(float x) { return __builtin_amdgcn_rcpf(1.f + __expf(-x)); }

constexpr int D = 2048, FF = 5504, NBATCH = 2, SEQ = 4096, LP = 4160, MR = NBATCH * LP, MP = 8448, NCH = 65;
constexpr int NIN = 17664, NGU = 2 * FF;
constexpr int ZQ_G = 0, ZK_G = 512, ZV_G = 1024, ZG_G = 2048, ZQ_R = 3072, ZK_R = 4096, ZV_R = 5120, ZG_R = 6144, ZQ_H = 7168, ZF_H = 8192, ZI_H = 9216, ZG_H = 10240, ZMG = 11264, ZLR = 17408;
constexpr float EPS = 1e-6f;
constexpr int NPOS = 4112;

constexpr size_t al256(size_t x) { return (x + 255) & ~(size_t)255; }
constexpr size_t WS_SSQ = 0;
constexpr size_t WS_ROPE = al256(WS_SSQ + (size_t)7 * MP * 8);
constexpr size_t WS_LAMG = al256(WS_ROPE + (size_t)NPOS * 128 * 8);
constexpr size_t WS_LAMH = al256(WS_LAMG + (size_t)520 * 128 * 4);
constexpr size_t WS_W = al256(WS_LAMH + (size_t)1040 * 128 * 4);
constexpr size_t W_GU1 = 0, W_D1 = W_GU1 + (size_t)NGU * D * 2, W_IN = W_D1 + (size_t)D * FF * 2, W_B = W_IN + (size_t)NIN * D * 2, W_O = W_B + (size_t)3 * D * 1024 * 2,
                 W_GU2 = W_O + (size_t)D * D * 2, W_D2 = W_GU2 + (size_t)NGU * D * 2, W_END = W_D2 + (size_t)D * FF * 2;
constexpr size_t WS_H = al256(WS_W + W_END);
constexpr size_t WS_HB = al256(WS_H + (size_t)MP * D * 4);
constexpr size_t WS_Z = al256(WS_HB + (size_t)MP * D * 2);
constexpr size_t WS_QT = al256(WS_Z + (size_t)MP * NIN * 2);
constexpr size_t WS_KT = al256(WS_QT + (size_t)MR * 2560 * 2);
constexpr size_t WS_VT = al256(WS_KT + (size_t)MR * 2560 * 2);
constexpr size_t WS_P = al256(WS_VT + (size_t)MR * 3072 * 2);
constexpr size_t WS_O = al256(WS_P + (size_t)2080 * 4096 * 2);
constexpr size_t WS_MF = WS_O, WS_MB = WS_O + (size_t)MP * D * 4;
constexpr size_t WS_YS = al256(WS_O + (size_t)MP * 3072 * 4);
constexpr size_t WS_PART = al256(WS_YS + (size_t)MP * 3072 * 2);
constexpr size_t WS_CNT = al256(WS_PART + (size_t)21 * 8 * 128 * 256 * 4);
constexpr size_t WS_BAR = al256(WS_CNT + 4096);
constexpr size_t WS_O2 = al256(WS_BAR + 16384);
constexpr size_t WS_END = al256(WS_O2 + (size_t)MR * 1024 * 4);
static_assert(WS_MB + (size_t)MP * D * 2 <= WS_YS, "MF|MB alias O");
constexpr size_t QT_G = 0, QT_R = (size_t)520 * 64 * 128, QT_H = QT_R + (size_t)520 * 64 * 256;
constexpr size_t VT_G = 0, VT_R = (size_t)520 * 256 * 64, VT_H = VT_R + (size_t)520 * 256 * 64;
constexpr size_t P_G = 0, P_R = (size_t)520 * 4096, P_H = (size_t)1040 * 4096;

namespace pg8 {
constexpr int BM = 256, BK = 64, HALF = 128, HTB = HALF * BK * 2, STAGE_BYTES = 8 * HTB, NXCD = 8, WGM = 8;
__host__ __device__ __forceinline__ int lds_byte(int r, int c) { const int st = (r >> 4) * 2 + (c >> 5), rr = r & 15, cc = c & 31, ob = rr * 64 + cc * 2; return st * 1024 + (ob ^ (((ob >> 9) & 1) << 5)); }
__host__ __device__ __forceinline__ void stage_rc(int b, int& R, int& C) { const int st = b / 1024, sb = b % 1024, swz = sb ^ (((sb >> 9) & 1) << 5); R = (st >> 1) * 16 + swz / 64; C = (st & 1) * 32 + (swz % 64) / 2; }
__host__ __device__ __forceinline__ int perm32(int rho) { const int n = rho >> 4, i = rho & 15; return 8 * (i >> 2) + 4 * n + (i & 3); }

struct Unit { int pm, pn, tag, nt, rowoff, half; };
struct Gemm { const bf16* A; const bf16* Bt; int lda, ldb, K; size_t a_tag, b_tag; int b_div; size_t b_hi; };

struct StaticOrder {
    int nM, nN, nwg, G, c, reps, nt_all;
    __device__ void init(int M, int N, int G_, int c_, int reps_, int K) { nM = M / BM; nN = N / BM; nwg = nM * nN; G = G_; c = c_; reps = reps_; nt_all = K / BK; }
    __device__ void tile(int L, Unit& u) const {
        int wgid = L; { const int q = nwg / NXCD, r = nwg % NXCD, xcd = wgid % NXCD, off = wgid / NXCD; wgid = (xcd < r ? xcd * (q + 1) : r * (q + 1) + (xcd - r) * q) + off; }
        const int nig = WGM * nN, gid = wgid / nig, fm = gid * WGM, gsz = (nM - fm) < WGM ? (nM - fm) : WGM;
        u.pm = fm + ((wgid % nig) % gsz); u.pn = (wgid % nig) / gsz; u.nt = nt_all; u.rowoff = 0; u.half = 0;
    }
    __device__ bool next(int i, Unit& u) const {
        const int rep = i % reps; const long L = (long)(i / reps) * G + c; if (L >= nwg) return false;
        tile((int)L, u); u.tag = rep; return true;
    }
};
struct MainRounds {
    StaticOrder B; int nfull;
    __device__ void init(int Mmain, int N, int G_, int c_, int K) { B.init(Mmain, N, G_, c_, 1, K); nfull = (B.nwg / G_) * G_; }
    __device__ bool next(int i, Unit& u) const { const int L = i * B.G + B.c; if (L >= nfull) return false; B.tile(L, u); u.tag = 0; return true; }
};
struct TailHalves {
    StaticOrder B; int nfull, ntail, PM;
    __device__ void init(int Mmain, int N, int G_, int c_, int K) { B.init(Mmain, N, G_, c_, 1, K); nfull = (B.nwg / G_) * G_; ntail = B.nwg - nfull; PM = Mmain / BM; }
    __device__ bool next(int i, Unit& u) const {
        int j = i * B.G + B.c; u.tag = 0;
        if (j < 2 * ntail) { B.tile(nfull + (j >> 1), u); u.rowoff = (j & 1) * HALF; u.half = 1; return true; }
        j -= 2 * ntail;
        if (j < B.nN) { u.pm = PM; u.pn = j; u.nt = B.nt_all; u.rowoff = 0; u.half = 1; return true; }
        return false;
    }
};
struct SplitOrder {
    int nN, nP, nG, G, c, PM, nt_tot;
    __device__ void init(int PM_, int N, int K, int groups, int G_, int c_) { PM = PM_; nN = N / BM; nt_tot = K / BK; nP = nt_tot / 4; nG = groups; G = G_; c = c_; }
    __device__ bool next(int i, Unit& u) const {
        const int L = i * G + c; if (L >= nN * nP * nG) return false;
        u.pm = PM; u.pn = L % nN; u.tag = L / nN; const int p = u.tag % nP; u.nt = (p == nP - 1) ? nt_tot - 4 * (nP - 1) : 4; u.rowoff = 0; u.half = 0; return true;
    }
};


template <bool HALF_>
struct EpiGateUpT {
    static constexpr bool PERM = true, CHAIN = false, HALF_ONLY = HALF_;
    bf16* O; const u64* ssq;
    __device__ __forceinline__ void operator()(const f32x4 (&acc)[2][2][4][2], const Unit& u, int wr, int wc, int fr, int fq) const {
        const int row0 = u.pm * BM + u.rowoff + wr * 64 + fr, col0 = u.pn * 128 + wc * 32 + 8 * fq;
#pragma unroll
        for (int ai = 0; ai < (HALF_ ? 1 : 2); ++ai) {
#pragma unroll
            for (int m = 0; m < 4; ++m) {
                const int row = row0 + ai * HALF + m * 16; const float rs = rsqrtf(ssq_get(ssq, row) * (1.f / D) + EPS);
                float a[8];
#pragma unroll
                for (int n = 0; n < 2; ++n)
#pragma unroll
                    for (int e = 0; e < 4; ++e) { const float g = acc[ai][0][m][n][e] * rs, uu = acc[ai][1][m][n][e] * rs; a[4 * n + e] = silu_f(g) * uu; }
                u32x4 w; w.x = cvtpk(a[0], a[1]); w.y = cvtpk(a[2], a[3]); w.z = cvtpk(a[4], a[5]); w.w = cvtpk(a[6], a[7]);
                *(u32x4*)(O + (size_t)row * FF + col0) = w; } }
    }
};
struct EpiRowScale {
    static constexpr bool PERM = true, CHAIN = false, HALF_ONLY = false;
    bf16* O; int ldc; const u64* ssq;
    __device__ __forceinline__ void operator()(const f32x4 (&acc)[2][2][4][2], const Unit& u, int wr, int wc, int fr, int fq) const {
        const int row0 = u.pm * BM + wr * 64 + fr, col0 = u.pn * BM + wc * 32 + 8 * fq;
#pragma unroll
        for (int ai = 0; ai < 2; ++ai)
#pragma unroll
            for (int m = 0; m < 4; ++m) {
                const int row = row0 + ai * HALF + m * 16; const float rs = rsqrtf(ssq_get(ssq, row) * (1.f / D) + EPS);
                bf16* rowp = O + (size_t)row * ldc + col0;
#pragma unroll
                for (int bj = 0; bj < 2; ++bj) { const f32x4 v0 = acc[ai][bj][m][0] * rs, v1 = acc[ai][bj][m][1] * rs;
                    u32x4 w; w.x = cvtpk(v0[0], v0[1]); w.y = cvtpk(v0[2], v0[3]); w.z = cvtpk(v1[0], v1[1]); w.w = cvtpk(v1[2], v1[3]);
                    *(u32x4*)(rowp + bj * HALF) = w; } }
    }
};
struct EpiResid {
    static constexpr bool PERM = true, CHAIN = false, HALF_ONLY = false;
    float* H32; bf16* HB; u64* ssq_out; float scale;
    __device__ __forceinline__ void operator()(const f32x4 (&acc)[2][2][4][2], const Unit& u, int wr, int wc, int fr, int fq) const {
        const int row0 = u.pm * BM + wr * 64 + fr, col0 = u.pn * BM + wc * 32 + 8 * fq;
#pragma unroll
        for (int ai = 0; ai < 2; ++ai)
#pragma unroll
            for (int m = 0; m < 4; ++m) {
                const int row = row0 + ai * HALF + m * 16; const size_t off = (size_t)row * D + col0; float s = 0.f;
#pragma unroll
                for (int bj = 0; bj < 2; ++bj) { const size_t o = off + bj * HALF; const u32x4 hb = *(const u32x4*)(HB + o);
                    f32x4 h0 = (f32x4){bflo(hb.x), bfhi(hb.x), bflo(hb.y), bfhi(hb.y)}, h1 = (f32x4){bflo(hb.z), bfhi(hb.z), bflo(hb.w), bfhi(hb.w)};
                    h0 = h0 + acc[ai][bj][m][0] * scale; h1 = h1 + acc[ai][bj][m][1] * scale;
                    if (H32) { *(f32x4*)(H32 + o) = h0; *(f32x4*)(H32 + o + 4) = h1; }
                    u32x4 w; w.x = cvtpk(h0[0], h0[1]); w.y = cvtpk(h0[2], h0[3]); w.z = cvtpk(h1[0], h1[1]); w.w = cvtpk(h1[2], h1[3]); *(u32x4*)(HB + o) = w;
                    s += ((h0[0] * h0[0] + h0[1] * h0[1]) + (h0[2] * h0[2] + h0[3] * h0[3])) + ((h1[0] * h1[0] + h1[1] * h1[1]) + (h1[2] * h1[2] + h1[3] * h1[3])); }
                s += __shfl_xor(s, 16); s += __shfl_xor(s, 32);
                if (fq == 0) atomicAdd(ssq_out + row, ssq_fix(s)); }
    }
};
struct EpiBranch {
    static constexpr bool PERM = false, CHAIN = true, HALF_ONLY = false;
    const bf16* Z; bf16* MB;
    __device__ __forceinline__ void operator()(f32x4 (&acc)[2][2][4][2], const Unit& u, int wr, int wc, int fr, int fq) const {
        const int row0 = u.pm * BM + wr * 64 + fr, col0 = u.pn * BM + wc * 32 + 4 * fq; const int n_br = u.tag;
#pragma unroll
        for (int ai = 0; ai < 2; ++ai)
#pragma unroll
            for (int m = 0; m < 4; ++m) {
                const int row = row0 + ai * HALF + m * 16; const size_t off = (size_t)row * D + col0; const bf16* zr = Z + (size_t)row * NIN + ZMG + n_br * D + col0;
#pragma unroll
                for (int bj = 0; bj < 2; ++bj)
#pragma unroll
                    for (int n = 0; n < 2; ++n) { const int co = bj * HALF + n * 16; const u32x2 gz = *(const u32x2*)(zr + co);
                        const float z0[4] = {bflo(gz.x), bfhi(gz.x), bflo(gz.y), bfhi(gz.y)}; f32x4 v = acc[ai][bj][m][n];
                        if (n_br < 2) { const u32x2 gn = *(const u32x2*)(zr + D + co); const float z1[4] = {bflo(gn.x), bfhi(gn.x), bflo(gn.y), bfhi(gn.y)};
#pragma unroll
                            for (int e = 0; e < 4; ++e) v[e] *= (1.f + __expf(-fminf(fmaxf(z1[e], -30.f), 30.f))) * __builtin_amdgcn_rcpf(1.f + __expf(-fminf(fmaxf(z0[e], -30.f), 30.f)));
                            acc[ai][bj][m][n] = v;
                        } else {
#pragma unroll
                            for (int e = 0; e < 4; ++e) v[e] *= __builtin_amdgcn_rcpf(1.f + __expf(-fminf(fmaxf(z0[e], -30.f), 30.f)));
                            u32x2 w; w.x = cvtpk(v[0], v[1]); w.y = cvtpk(v[2], v[3]); *(u32x2*)(MB + off + co) = w; } } }
    }
};
__device__ __forceinline__ void wt_store4(float* p, f32x4 v) {
    __hip_atomic_store((u64*)p, ((u64)__float_as_uint(v[1]) << 32) | __float_as_uint(v[0]), __ATOMIC_RELAXED, __HIP_MEMORY_SCOPE_AGENT);
    __hip_atomic_store((u64*)p + 1, ((u64)__float_as_uint(v[3]) << 32) | __float_as_uint(v[2]), __ATOMIC_RELAXED, __HIP_MEMORY_SCOPE_AGENT);
}
__device__ __forceinline__ f32x4 wt_load4(const float* p) {
    const u64 a = __hip_atomic_load((const u64*)p, __ATOMIC_RELAXED, __HIP_MEMORY_SCOPE_AGENT), b = __hip_atomic_load((const u64*)p + 1, __ATOMIC_RELAXED, __HIP_MEMORY_SCOPE_AGENT);
    return (f32x4){__uint_as_float((unsigned)a), __uint_as_float((unsigned)(a >> 32)), __uint_as_float((unsigned)b), __uint_as_float((unsigned)(b >> 32))};
}
__device__ __forceinline__ void split_store(const f32x4 (&acc)[2][2][4][2], float* part, int wr, int wc, int fr, int fq) {
#pragma unroll
    for (int m = 0; m < 4; ++m)
#pragma unroll
        for (int bj = 0; bj < 2; ++bj)
#pragma unroll
            for (int n = 0; n < 2; ++n) wt_store4(part + (size_t)(wr * 64 + m * 16 + fr) * 256 + bj * HALF + wc * 32 + n * 16 + 4 * fq, acc[0][bj][m][n]);
}
struct EpiSplitStore {
    static constexpr bool PERM = false, CHAIN = false, HALF_ONLY = false;
    unsigned char* ws; int cnt_idx;
    __device__ __forceinline__ void operator()(const f32x4 (&acc)[2][2][4][2], const Unit& u, int wr, int wc, int fr, int fq) const {
        split_store(acc, (float*)(ws + WS_PART) + (size_t)(u.tag * 8 + u.pn) * 128 * 256, wr, wc, fr, fq);
        asm volatile("s_waitcnt vmcnt(0)" ::: "memory");
        __syncthreads();
        if ((wr | wc | fr | fq) == 0) __hip_atomic_fetch_add((unsigned*)(ws + WS_CNT) + cnt_idx + u.pn, 1u, __ATOMIC_RELAXED, __HIP_MEMORY_SCOPE_AGENT);
    }
};
__device__ __forceinline__ void split_wait(unsigned* cnt, unsigned total, int tid) {
    if (tid == 0) { unsigned spins = 0; while (__hip_atomic_load(cnt, __ATOMIC_RELAXED, __HIP_MEMORY_SCOPE_AGENT) < total && ++spins < (1u << 22)) __builtin_amdgcn_s_sleep(1); }
    __syncthreads();
}
__device__ __forceinline__ void split_finish_resid(unsigned char* ws, int ssq_idx, float scale, int cnt_idx, int nP, int pm, int unit, int tid, bool keep32) {
    if (unit >= 8 * nP) return;
    const int pn = unit % 8, tag = unit / 8;
    float* const H32 = (float*)(ws + WS_H); bf16* const HB = (bf16*)(ws + WS_HB); u64* const ssq_out = (u64*)(ws + WS_SSQ) + (size_t)ssq_idx * MP; const float* const PART = (const float*)(ws + WS_PART);
    split_wait((unsigned*)(ws + WS_CNT) + cnt_idx + pn, (unsigned)nP, tid);
    const int wave = tid >> 6, lane = tid & 63;
    for (int rl = tag + nP * wave; rl < 128; rl += nP * 8) {
        f32x4 a = (f32x4){0.f, 0.f, 0.f, 0.f};
        const float* pp = PART + ((size_t)pn * 128 + rl) * 256 + 4 * lane;
#pragma unroll 8
        for (int p = 0; p < nP; ++p) a = a + wt_load4(pp + (size_t)p * 8 * 128 * 256);
        const int row = pm * BM + rl; const size_t off = (size_t)row * D + pn * BM + 4 * lane;
        const u32x2 hb = *(const u32x2*)(HB + off); f32x4 hv = (f32x4){bflo(hb.x), bfhi(hb.x), bflo(hb.y), bfhi(hb.y)}; hv = hv + a * scale; if (keep32) *(f32x4*)(H32 + off) = hv;
        u32x2 w; w.x = cvtpk(hv[0], hv[1]); w.y = cvtpk(hv[2], hv[3]); *(u32x2*)(HB + off) = w;
        float sq = (hv[0] * hv[0] + hv[1] * hv[1]) + (hv[2] * hv[2] + hv[3] * hv[3]);
#pragma unroll
        for (int o = 1; o < 64; o <<= 1) sq += __shfl_xor(sq, o);
        if (lane == 0) atomicAdd(ssq_out + row, ssq_fix(sq));
    }
}
__device__ __forceinline__ void split_finish_branch(unsigned char* ws, int cnt_idx, int nP, int pm, int unit, int tid) {
    const int nU = 3 * nP;
    if (unit >= 8 * nU) return;
    const int pn = unit % 8, tag = unit / 8;
    const bf16* const Z = (const bf16*)(ws + WS_Z); bf16* const MB = (bf16*)(ws + WS_MB); const float* const PART = (const float*)(ws + WS_PART);
    split_wait((unsigned*)(ws + WS_CNT) + cnt_idx + pn, (unsigned)nU, tid);
    const int wave = tid >> 6, lane = tid & 63;
    for (int rl = tag + nU * wave; rl < 128; rl += nU * 8) {
        const int row = pm * BM + rl; const size_t off = (size_t)row * D + pn * BM + 4 * lane;
        const float* pp = PART + ((size_t)pn * 128 + rl) * 256 + 4 * lane;
        f32x4 v = (f32x4){0.f, 0.f, 0.f, 0.f};
#pragma unroll
        for (int nb = 0; nb < 3; ++nb) { f32x4 a = (f32x4){0.f, 0.f, 0.f, 0.f};
            for (int p = 0; p < nP; ++p) a = a + wt_load4(pp + (size_t)(nb * nP + p) * 8 * 128 * 256);
            const u32x2 gz = *(const u32x2*)(Z + (size_t)row * NIN + ZMG + nb * D + pn * BM + 4 * lane);
            v[0] += a[0] * sigmoid_f(bflo(gz.x)); v[1] += a[1] * sigmoid_f(bfhi(gz.x)); v[2] += a[2] * sigmoid_f(bflo(gz.y)); v[3] += a[3] * sigmoid_f(bfhi(gz.y)); }
        u32x2 w; w.x = cvtpk(v[0], v[1]); w.y = cvtpk(v[2], v[3]); *(u32x2*)(MB + off) = w;
    }
}

template <class Epi, class Sched>
__device__ __forceinline__ void gemm_phase(LAS unsigned char* lds, const Gemm g, const Sched& S, const Epi& E, const int tid) {
    const int wid = __builtin_amdgcn_readfirstlane(tid >> 6), lane = tid & 63, wr = wid >> 2, wc = wid & 3, fr = lane & 15, fq = lane >> 4;
    unsigned voffA[2], voffB[2];
#pragma unroll
    for (int i = 0; i < 2; ++i) { int R, C; stage_rc(tid * 16 + i * 8192, R, C); const int Rb = Epi::PERM ? ((R & ~31) + perm32(R & 31)) : R;
        voffA[i] = (unsigned)(R * g.lda + C) * 2u; voffB[i] = (unsigned)(Rb * g.ldb + C) * 2u; }
    const size_t kstep = (size_t)(BK * 2);
    const size_t hstepA = (size_t)HALF * g.lda * 2, hstepB = (size_t)HALF * g.ldb * 2;
    const size_t tstepA = 2 * hstepA, tstepB = 2 * hstepB;
    const unsigned ldsw = (unsigned)wid * 1024u;
    const int aoff = lds_byte(wr * 64 + fr, fq * 8), boff = lds_byte(wc * 32 + fr, fq * 8);
#define PG8_SA(b, h) (((b) * 2 + (h)) * HTB)
#define PG8_SB(b, h) ((4 + (b) * 2 + (h)) * HTB)
#define PG8_STAGE(bufoff, gbase, voff) do { _Pragma("unroll") for (int _i = 0; _i < 2; ++_i) \
        __builtin_amdgcn_global_load_lds((const unsigned*)((const char*)(gbase) + (voff)[_i]), (LAS unsigned*)(lds + (bufoff) + ldsw + _i * 8192), 16, 0, 0); } while (0)
#define PG8_LDA(dst, b, h) do { _Pragma("unroll") for (int m = 0; m < 4; ++m) _Pragma("unroll") for (int k = 0; k < 2; ++k) dst[m][k] = *(const LAS bf16x8*)(lds + PG8_SA(b, h) + aoff + m * 2048 + k * 1024); } while (0)
#define PG8_LDB(dst, b, h) do { _Pragma("unroll") for (int n = 0; n < 2; ++n) _Pragma("unroll") for (int k = 0; k < 2; ++k) dst[n][k] = *(const LAS bf16x8*)(lds + PG8_SB(b, h) + boff + n * 2048 + k * 1024); } while (0)
#define PG8_MMA(ai, bj, At, Bt) do { __builtin_amdgcn_s_setprio(1); _Pragma("unroll") for (int m = 0; m < 4; ++m) _Pragma("unroll") for (int n = 0; n < 2; ++n) _Pragma("unroll") for (int k = 0; k < 2; ++k) \
        acc[ai][bj][m][n] = __builtin_amdgcn_mfma_f32_16x16x32_bf16(Bt[n][k], At[m][k], acc[ai][bj][m][n], 0, 0, 0); __builtin_amdgcn_s_setprio(0); } while (0)
#define PG8_WAIT_V(n) asm volatile("s_waitcnt vmcnt(" #n ")" ::: "memory")
#define PG8_WAIT_L(n) asm volatile("s_waitcnt lgkmcnt(" #n ")" ::: "memory")
#define PG8_BAR __builtin_amdgcn_s_barrier()
#define PG8_SCHED __builtin_amdgcn_sched_barrier(0)
    Unit cur, nxt; int ui = 0;
    if (!S.next(0, cur)) return;
    float z0 = 0.f; asm volatile("" : "+v"(z0));
    f32x4 acc[2][2][4][2];
#pragma unroll
    for (int a = 0; a < 2; ++a)
#pragma unroll
        for (int b = 0; b < 2; ++b)
#pragma unroll
            for (int m = 0; m < 4; ++m)
#pragma unroll
                for (int n = 0; n < 2; ++n) acc[a][b][m][n] = (f32x4){z0, z0, z0, z0};
    bf16x8 At[4][2], B0[2][2], B1[2][2];
    const char* cA = (const char*)g.A + (size_t)cur.pm * tstepA + (size_t)cur.rowoff * g.lda * 2 + (size_t)cur.tag * g.a_tag; const char* cB = (const char*)g.Bt + (size_t)cur.pn * tstepB + (size_t)(cur.tag % g.b_div) * g.b_tag + (size_t)(cur.tag / g.b_div) * g.b_hi;
    PG8_STAGE(PG8_SB(0, 0), cB, voffB); PG8_STAGE(PG8_SB(0, 1), cB + hstepB, voffB); PG8_STAGE(PG8_SA(0, 0), cA, voffA); PG8_STAGE(PG8_SA(0, 1), cA + hstepA, voffA);
    if (wr == 1) PG8_BAR;
    PG8_WAIT_V(2); PG8_BAR;
    PG8_STAGE(PG8_SB(1, 0), cB + kstep, voffB); PG8_STAGE(PG8_SA(1, 0), cA + kstep, voffA); PG8_STAGE(PG8_SB(1, 1), cB + hstepB + kstep, voffB);
    PG8_WAIT_V(6); PG8_BAR;
    for (;;) {
        const bool has_next = S.next(ui + 1, nxt);
        const char* nA = has_next ? (const char*)g.A + (size_t)nxt.pm * tstepA + (size_t)nxt.rowoff * g.lda * 2 + (size_t)nxt.tag * g.a_tag : cA;
        const char* nB = has_next ? (const char*)g.Bt + (size_t)nxt.pn * tstepB + (size_t)(nxt.tag % g.b_div) * g.b_tag + (size_t)(nxt.tag / g.b_div) * g.b_hi : cB;
        const int nt = cur.nt;
        for (int t = 0; t < nt; t += 2) {
            const bool last = (t == nt - 2);
            const char* a1 = cA + (size_t)(t + 1) * kstep;
            const char* a2 = last ? nA : cA + (size_t)(t + 2) * kstep; const char* b2 = last ? nB : cB + (size_t)(t + 2) * kstep;
            const char* a3 = a2 + kstep; const char* b3 = b2 + kstep;
            PG8_LDB(B0, 0, 0); PG8_LDB(B1, 0, 1); PG8_SCHED; PG8_LDA(At, 0, 0); PG8_STAGE(PG8_SA(1, 1), a1 + hstepA, voffA);
            PG8_WAIT_V(8); PG8_WAIT_L(0); PG8_BAR; PG8_MMA(0, 0, At, B0); PG8_MMA(0, 1, At, B1); PG8_BAR; PG8_SCHED;
            PG8_LDA(At, 0, 1); PG8_STAGE(PG8_SB(0, 0), b2, voffB); PG8_STAGE(PG8_SB(0, 1), b2 + hstepB, voffB); PG8_STAGE(PG8_SA(0, 0), a2, voffA);
            PG8_WAIT_V(8); PG8_WAIT_L(0); PG8_BAR; if constexpr (!Epi::HALF_ONLY) { PG8_MMA(1, 0, At, B0); PG8_MMA(1, 1, At, B1); } PG8_BAR; PG8_SCHED;
            PG8_LDB(B0, 1, 0); PG8_LDB(B1, 1, 1); PG8_SCHED; PG8_LDA(At, 1, 0); PG8_STAGE(PG8_SA(0, 1), a2 + hstepA, voffA);
            PG8_WAIT_V(8); PG8_WAIT_L(0); PG8_BAR; PG8_MMA(0, 0, At, B0); PG8_MMA(0, 1, At, B1); PG8_BAR; PG8_SCHED;
            PG8_LDA(At, 1, 1); PG8_STAGE(PG8_SB(1, 0), b3, voffB); PG8_STAGE(PG8_SB(1, 1), b3 + hstepB, voffB); PG8_STAGE(PG8_SA(1, 0), a3, voffA);
            PG8_WAIT_V(8); PG8_WAIT_L(0); PG8_BAR; if constexpr (!Epi::HALF_ONLY) { PG8_MMA(1, 0, At, B0); PG8_MMA(1, 1, At, B1); } PG8_BAR; PG8_SCHED;
        }
        if (wr == 0) PG8_BAR;
        E(acc, cur, wr, wc, fr, fq);
        if (!has_next) break;
        if (!Epi::CHAIN || cur.tag == 2) {
#pragma unroll
        for (int a = 0; a < 2; ++a)
#pragma unroll
            for (int b = 0; b < 2; ++b)
#pragma unroll
                for (int m = 0; m < 4; ++m)
#pragma unroll
                    for (int n = 0; n < 2; ++n) acc[a][b][m][n] = (f32x4){z0, z0, z0, z0};
        }
        cur = nxt; cA = nA; cB = nB; ++ui;
        if (wr == 1) PG8_BAR;
    }
    PG8_WAIT_V(0);
    PG8_BAR;
#undef PG8_SA
#undef PG8_SB
#undef PG8_STAGE
#undef PG8_LDA
#undef PG8_LDB
#undef PG8_MMA
#undef PG8_WAIT_V
#undef PG8_WAIT_L
#undef PG8_BAR
#undef PG8_SCHED
}
}

constexpr int LDS_BYTES = 147456;
constexpr int NPHASE = 22;

struct Args { const float* in[21]; float* out; unsigned char* ws; int ph_lo, ph_hi; };

struct Frame {
    LAS unsigned char* lds;
    int tid, lane, wave, vcu, G, bid;
    const float* const* in;
    unsigned char* ws;
};

__device__ __forceinline__ float wave_sum(float v) {
#pragma unroll
    for (int o = 1; o < 64; o <<= 1) v += __shfl_xor(v, o);
    return v;
}

__device__ __forceinline__ void conv_item(const float* W, int ldw, int col0, int nvalid, const float* gain, float scale, bf16* dst, int K, int k0, LAS float* scr, int lane) {
    const int n4 = (lane & 15) * 4, kq = lane >> 4;
    const float* wp = W + (size_t)(k0 + kq) * ldw + col0 + n4; const size_t wstep = (size_t)4 * ldw;
    f32x4 v[16];
#pragma unroll
    for (int i = 0; i < 16; ++i) { v[i] = (f32x4){0.f, 0.f, 0.f, 0.f}; if (n4 < nvalid) v[i] = *(const GAS f32x4*)(wp + (size_t)i * wstep); }
#pragma unroll
    for (int i = 0; i < 16; ++i) { const int kk = 4 * i + kq; const float g = (gain ? gain[k0 + kk] : 1.f) * scale; LAS float* sp = scr + kk * 65 + n4;
        sp[0] = v[i][0] * g; sp[1] = v[i][1] * g; sp[2] = v[i][2] * g; sp[3] = v[i][3] * g; }
    asm volatile("s_waitcnt lgkmcnt(0)" ::: "memory");
    const int c = lane & 7;
#pragma unroll
    for (int j = 0; j < 8; ++j) { const int n = (lane >> 3) + 8 * j; const LAS float* s = scr + (8 * c) * 65 + n;
        u32x4 o; o.x = cvtpk(s[0 * 65], s[1 * 65]); o.y = cvtpk(s[2 * 65], s[3 * 65]); o.z = cvtpk(s[4 * 65], s[5 * 65]); o.w = cvtpk(s[6 * 65], s[7 * 65]);
        *(GAS u32x4*)(dst + (size_t)n * K + 8 * c) = o; }
    asm volatile("s_waitcnt lgkmcnt(0)" ::: "memory");
}

constexpr int CI_GU = (NGU / 64) * (D / 64), CI_D = (D / 64) * (FF / 64), CI_IN = (NIN / 64) * (D / 64), CI_B = 3 * (D / 64) * (1024 / 64), CI_O = (D / 64) * (D / 64);
constexpr int CI_PARTA = CI_GU + CI_D + CI_IN, CI_ALL = CI_PARTA + CI_B + CI_O + CI_GU + CI_D;
__device__ __forceinline__ void convert_range(Frame& F, int L, int lo, int hi, int gw, int NGW) {
    LAS float* scr = (LAS float*)(F.lds + F.wave * 16640);
    unsigned char* wb = F.ws + WS_W;
    for (int it = lo + gw; it < hi; it += NGW) {
        int r = it, f = 0;
        if (r >= CI_PARTA + CI_B + CI_O) { f = 1; r -= CI_PARTA + CI_B + CI_O; }
        const float* W; const float* gain = nullptr; bf16* dst; int ldw, col0, nvalid = 64, K, kb; float sc = 1.f;
        if (r < CI_GU) {
            const int nb = r % (NGU / 64); kb = r / (NGU / 64);
            const int j = nb >> 2, half = (nb >> 1) & 1, sub = nb & 1;
            W = (half ? F.in[f ? 18 : 4] : F.in[f ? 17 : 3]) + (size_t)L * D * FF; gain = F.in[f ? 16 : 2] + (size_t)L * D; ldw = FF; col0 = j * 128 + sub * 64; K = D;
            dst = (bf16*)(wb + (f ? W_GU2 : W_GU1)) + (size_t)(nb * 64) * D;
        } else if (r < CI_GU + CI_D) { r -= CI_GU;
            const int nb = r % (D / 64); kb = r / (D / 64);
            W = F.in[f ? 19 : 5] + (size_t)L * FF * D; ldw = D; col0 = nb * 64; K = FF;
            dst = (bf16*)(wb + (f ? W_D2 : W_D1)) + (size_t)(nb * 64) * FF;
        } else if (r < CI_PARTA) { r -= CI_GU + CI_D;
            const int nb = r % (NIN / 64); kb = r / (NIN / 64); const int n0 = nb * 64;
            if (n0 < 3072) col0 = n0; else if (n0 < ZLR) col0 = n0 + 16; else if (n0 == ZLR) { col0 = 3072; nvalid = 16; } else { col0 = 0; nvalid = 0; }
            if (n0 < 512) sc = 0.08838834764831845f;
            else if (n0 >= ZQ_R && n0 < ZK_R) sc = 0.0625f;
            W = F.in[7] + (size_t)L * D * 17424; gain = F.in[6] + (size_t)L * D; ldw = 17424; K = D;
            dst = (bf16*)(wb + W_IN) + (size_t)n0 * D;
        } else if (r < CI_PARTA + CI_B) { r -= CI_PARTA;
            const int n = r / (CI_B / 3); r -= n * (CI_B / 3); const int nb = r % (D / 64); kb = r / (D / 64);
            W = F.in[14] + ((size_t)L * 3 + n) * 1024 * D; ldw = D; col0 = nb * 64; K = 1024;
            dst = (bf16*)(wb + W_B) + ((size_t)n * D + nb * 64) * 1024;
        } else { r -= CI_PARTA + CI_B;
            const int nb = r % (D / 64); kb = r / (D / 64);
            W = F.in[15] + (size_t)L * D * D; ldw = D; col0 = nb * 64; K = D;
            dst = (bf16*)(wb + W_O) + (size_t)(nb * 64) * D; }
        conv_item(W, ldw, col0, nvalid, gain, sc, dst + kb * 64, K, kb * 64, scr, F.lane);
    }
}

__device__ __forceinline__ void init_phase(Frame& F) {
    const int gw = F.vcu * 8 + F.wave, NGW = F.G * 8;
    float* H = (float*)(F.ws + WS_H); bf16* HB = (bf16*)(F.ws + WS_HB); u64* ssq = (u64*)(F.ws + WS_SSQ);
    for (int r = gw; r < MP; r += NGW) {
        const float* src = nullptr;
        if (r < MR) { const int b = r / LP, p = r % LP; if (p >= 64) src = F.in[0] + ((size_t)b * SEQ + (p - 64)) * D; else if (p >= 48) src = F.in[1] + (size_t)(p - 48) * D; }
        f32x4 v[8]; float s = 0.f;
#pragma unroll
        for (int j = 0; j < 8; ++j) { v[j] = src ? ((const GAS f32x4*)src)[F.lane + 64 * j] : (f32x4){0.f, 0.f, 0.f, 0.f}; s += (v[j][0] * v[j][0] + v[j][1] * v[j][1]) + (v[j][2] * v[j][2] + v[j][3] * v[j][3]); }
        s = wave_sum(s);
#pragma unroll
        for (int j = 0; j < 8; ++j) { u32x2 w; w.x = cvtpk(v[j][0], v[j][1]); w.y = cvtpk(v[j][2], v[j][3]); ((GAS u32x2*)(HB + (size_t)r * D))[F.lane + 64 * j] = w; }
        if (F.lane == 0) ((GAS u64*)ssq)[r] = ssq_fix(s);
    }
    const int gt = F.vcu * 512 + F.tid, NT = F.G * 512;
    for (int i = gt; i < 6 * MP; i += NT) ssq[MP + i] = 0ull;
    if (gt < 1024) ((unsigned*)(F.ws + WS_CNT))[gt] = 0u;
    float* rope = (float*)(F.ws + WS_ROPE);
    for (int i = gt; i < NPOS * 128; i += NT) { const int pos = i >> 7, k = i & 127;
        const float inv = exp2f(-(float)k * (13.287712379549449f / 128.f)); const float ang = (float)pos * inv;
        const double rev = (double)ang * 0.15915494309189535; const float fr = (float)(rev - __builtin_rint(rev));
        rope[2 * i] = __builtin_amdgcn_cosf(fr); rope[2 * i + 1] = __builtin_amdgcn_sinf(fr); }
}

template <int DV>
__device__ __forceinline__ void write_vT(int tid, const bf16* Zv  , bf16* VTci, bool do_silu) {
#pragma unroll
    for (int n = 0; n < DV / 128; ++n) { const int idx = tid + 512 * n, e = idx % DV, jb = idx / DV; unsigned w[8];
#pragma unroll
        for (int jj = 0; jj < 8; ++jj) { unsigned short v0 = Zv[(size_t)(16 * jb + 2 * jj) * NIN + e], v1 = Zv[(size_t)(16 * jb + 2 * jj + 1) * NIN + e];
            if (do_silu) w[jj] = cvtpk(silu_f(bf2f(v0)), silu_f(bf2f(v1))); else w[jj] = (unsigned)v0 | ((unsigned)v1 << 16); }
        GAS u32x4* dst = (GAS u32x4*)(VTci + (size_t)e * 64 + 16 * jb); dst[0] = (u32x4){w[0], w[1], w[2], w[3]}; dst[1] = (u32x4){w[4], w[5], w[6], w[7]}; }
}

template <int NC>
__device__ __forceinline__ void stage_tile(LAS unsigned char* dst, const bf16* src, int tid) {
#pragma unroll
    for (int n = 0; n < (64 * NC / 8) / 512; ++n) { const int idx = tid + 512 * n, row = idx / (NC / 8), cp = idx % (NC / 8);
        *(LAS u32x4*)(dst + row * (NC * 2) + cp * 16) = *(const GAS u32x4*)(src + (size_t)row * NIN + cp * 8); }
}
template <int DV>
__device__ __forceinline__ void write_vT_lds(int tid, const LAS unsigned short* vs, bf16* VTci, bool do_silu) {
#pragma unroll
    for (int n = 0; n < DV / 128; ++n) { const int idx = tid + 512 * n, e = idx % DV, jb = idx / DV; unsigned w[8];
#pragma unroll
        for (int jj = 0; jj < 8; ++jj) { const unsigned short v0 = vs[(16 * jb + 2 * jj) * DV + e], v1 = vs[(16 * jb + 2 * jj + 1) * DV + e];
            if (do_silu) w[jj] = cvtpk(silu_f(bf2f(v0)), silu_f(bf2f(v1))); else w[jj] = (unsigned)v0 | ((unsigned)v1 << 16); }
        GAS u32x4* dst = (GAS u32x4*)(VTci + (size_t)e * 64 + 16 * jb); dst[0] = (u32x4){w[0], w[1], w[2], w[3]}; dst[1] = (u32x4){w[4], w[5], w[6], w[7]}; }
}

constexpr int PR_W2S = 0, PR_BS = 8192, PR_GLR = 8704, PR_TOT = 12800, PR_QH = 14848, PR_HB = 32 * 272, PR_KH = PR_QH + 3 * PR_HB, PR_END = PR_KH + 3 * PR_HB, PR_RAWQ = PR_END, PR_RAWK = PR_RAWQ + 16384, PR_RAWV = PR_RAWK + 16384;
template <int BR>
__device__ __forceinline__ void prep_gh(Frame& F, int L, int item) {
    constexpr int H = BR == 0 ? 4 : 8, DV = BR == 0 ? 256 : 128;
    const int h = item % H, bc = item / H, c = bc % NCH, b = bc / NCH, rowb = b * LP + c * 64, ci = item;
    LAS float* w2s = (LAS float*)(F.lds + PR_W2S); LAS float* bs = (LAS float*)(F.lds + PR_BS); LAS float* glr = (LAS float*)(F.lds + PR_GLR); LAS float* tot = (LAS float*)(F.lds + PR_TOT);
    int t_ = F.tid; asm volatile("" : "+v"(t_));
    const int t = t_, d = t & 127, i0 = t >> 7;
    const bf16* Z = (const bf16*)(F.ws + WS_Z) + (size_t)rowb * NIN;
    float lbv = 0.f;
    stage_tile<128>(F.lds + PR_RAWQ, Z + (BR == 0 ? ZQ_G : ZQ_H) + h * 128, t);
    stage_tile<128>(F.lds + PR_RAWK, Z + (BR == 0 ? ZK_G : ZF_H) + h * 128, t);
    stage_tile<DV>(F.lds + PR_RAWV, Z + (BR == 0 ? ZV_G : ZI_H) + h * DV, t);
    if (BR == 0) {
        const float* w2 = F.in[8] + (size_t)L * 16 * 512; const float* bg = F.in[9] + (size_t)L * 512;
        for (int idx = t; idx < 2048; idx += 512) w2s[idx] = ((const GAS float*)w2)[(idx >> 7) * 512 + h * 128 + (idx & 127)];
        if (t < 128) bs[t] = ((const GAS float*)bg)[h * 128 + t];
        for (int idx = t; idx < 1024; idx += 512) glr[idx] = bf2f(((const GAS bf16*)Z)[(size_t)(idx >> 4) * NIN + ZLR + (idx & 15)]);
    } else if (L == 1) {
        const float l0 = F.in[12][h * 128 + d], l1 = F.in[12][1024 + h * 128 + d]; const float mx = fmaxf(l0, l1), e0 = __expf(l0 - mx), e1 = __expf(l1 - mx); lbv = e1 / (e0 + e1);
    }
    __syncthreads();
    float qv[16], kv[16], cv[16]; float run = 0.f;
    unsigned short rawq[16], rawk[16];
#pragma unroll
    for (int ii = 0; ii < 16; ++ii) { rawq[ii] = ((const LAS unsigned short*)(F.lds + PR_RAWQ))[(16 * i0 + ii) * 128 + d]; rawk[ii] = ((const LAS unsigned short*)(F.lds + PR_RAWK))[(16 * i0 + ii) * 128 + d]; }
#pragma unroll
    for (int ii = 0; ii < 16; ++ii) { const int i = 16 * i0 + ii; float q = bf2f(rawq[ii]), k, gl;
        if (BR == 0) { k = bf2f(rawk[ii]); float x = bs[d];
#pragma unroll
            for (int j = 0; j < 16; ++j) x += glr[i * 16 + j] * w2s[j * 128 + d];
            gl = (fminf(x, 0.f) - __logf(1.f + __expf(-fabsf(x)))) * (1.f / 16.f);
        } else { const float hf = bf2f(rawk[ii]); const float e = __expf(fminf(-hf, 80.f)), sg = __builtin_amdgcn_rcpf(1.f + e);
            gl = __logf(fmaxf(lbv + (1.f - lbv) * sg, 1e-20f)); k = (1.f - lbv) * e * sg; }
        run += gl; qv[ii] = q; kv[ii] = k; cv[ii] = run;
        if ((ii & 3) == 3) __builtin_amdgcn_sched_barrier(0); }
    tot[i0 * 128 + d] = run;
    __syncthreads();
    const float t0 = tot[d], t1 = tot[128 + d], t2 = tot[256 + d], t3 = tot[384 + d];
    const float r15 = t0, r31 = t0 + t1, r47 = r31 + t2, last = r47 + t3;
    const float off = i0 == 0 ? 0.f : (i0 == 1 ? r15 : (i0 == 2 ? r31 : r47));
#pragma unroll
    for (int ii = 0; ii < 16; ++ii) cv[ii] += off;
    bf16* QT = (bf16*)(F.ws + WS_QT) + (BR == 0 ? QT_G : QT_H) + (size_t)ci * 64 * 128;
    bf16* KT = (bf16*)(F.ws + WS_KT) + (BR == 0 ? QT_G : QT_H) + (size_t)ci * 128 * 64;
    bf16* Pm = (bf16*)(F.ws + WS_P) + (BR == 0 ? P_G : P_H) + (size_t)ci * 4096;
    float* LAM = (float*)(F.ws + (BR == 0 ? WS_LAMG : WS_LAMH)) + (size_t)ci * 128;
#pragma unroll
    for (int ii = 0; ii < 16; ++ii) ((GAS bf16*)QT)[(16 * i0 + ii) * 128 + d] = f2bf(qv[ii] * __expf(cv[ii]));
    if (i0 == 0) ((GAS float*)LAM)[d] = __expf(last);
    { unsigned w[8];
#pragma unroll
      for (int jj = 0; jj < 8; ++jj) w[jj] = cvtpk(kv[2 * jj] * __expf(last - cv[2 * jj]), kv[2 * jj + 1] * __expf(last - cv[2 * jj + 1]));
      GAS u32x4* dst = (GAS u32x4*)(KT + (size_t)d * 64 + 16 * i0); dst[0] = (u32x4){w[0], w[1], w[2], w[3]}; dst[1] = (u32x4){w[4], w[5], w[6], w[7]}; }
    {
        LAS unsigned short* QH = (LAS unsigned short*)(F.lds + PR_QH); LAS unsigned short* KH = (LAS unsigned short*)(F.lds + PR_KH);
        const int il = (16 * i0) & 31;
        if (i0 < 2) {
#pragma unroll
            for (int ii = 0; ii < 16; ++ii) { const int o = (il + ii) * 136 + d;
                QH[o] = f2bf(qv[ii] * __expf(fminf(cv[ii] - r15, 80.f))); KH[o] = f2bf(kv[ii] * __expf(fminf(r15 - cv[ii], 80.f))); KH[(PR_HB / 2) + o] = f2bf(kv[ii] * __expf(r31 - cv[ii])); }
        } else {
#pragma unroll
            for (int ii = 0; ii < 16; ++ii) { const int o = (il + ii) * 136 + d;
                QH[(PR_HB / 2) + o] = f2bf(qv[ii] * __expf(cv[ii] - r31)); QH[2 * (PR_HB / 2) + o] = f2bf(qv[ii] * __expf(fminf(cv[ii] - r47, 80.f))); KH[2 * (PR_HB / 2) + o] = f2bf(kv[ii] * __expf(fminf(r47 - cv[ii], 80.f))); }
        }
    }
    __syncthreads();
    { const int w = F.wave, r = F.lane & 15, q = F.lane >> 4;
#pragma unroll
      for (int tt = 0; tt < 2; ++tt) { const int T = w + 8 * tt, ti = T >> 2, tj = T & 3, I = ti >> 1, J = tj >> 1; f32x4 acc = (f32x4){0.f, 0.f, 0.f, 0.f};
          if (J <= I) { const int blk = I == 0 ? 0 : (J == 0 ? 1 : 2);
              const LAS unsigned char* qa = F.lds + PR_QH + blk * PR_HB + (16 * (ti & 1) + r) * 272 + 16 * q; const LAS unsigned char* kb = F.lds + PR_KH + blk * PR_HB + (16 * (tj & 1) + r) * 272 + 16 * q;
              __builtin_amdgcn_s_setprio(1);
#pragma unroll
              for (int k = 0; k < 4; ++k) acc = __builtin_amdgcn_mfma_f32_16x16x32_bf16(*(const LAS bf16x8*)(kb + 64 * k), *(const LAS bf16x8*)(qa + 64 * k), acc, 0, 0, 0);
              __builtin_amdgcn_s_setprio(0); }
          const int i = 16 * ti + r, j0 = 16 * tj + 4 * q;
          u32x2 pw; pw.x = cvtpk(j0 <= i ? acc[0] : 0.f, j0 + 1 <= i ? acc[1] : 0.f); pw.y = cvtpk(j0 + 2 <= i ? acc[2] : 0.f, j0 + 3 <= i ? acc[3] : 0.f);
          *(GAS u32x2*)(Pm + i * 64 + j0) = pw; } }
    write_vT_lds<DV>(t, (const LAS unsigned short*)(F.lds + PR_RAWV), (bf16*)(F.ws + WS_VT) + (BR == 0 ? VT_G : VT_H) + (size_t)ci * DV * 64, BR == 2);
    __syncthreads();
}

constexpr int RR_Q = 0, RR_K = 64 * 528, RR_RAWQ = 2 * 64 * 528, RR_RAWK = RR_RAWQ + 32768;
__device__ __forceinline__ void prep_ret(Frame& F, int item) {
    const int h = item % 4, bc = item / 4, c = bc % NCH, b = bc / NCH, rowb = b * LP + c * 64, ci = item;
    LAS unsigned short* QR = (LAS unsigned short*)(F.lds + RR_Q); LAS unsigned short* KR = (LAS unsigned short*)(F.lds + RR_K);
    int t_ = F.tid; asm volatile("" : "+v"(t_));
    const int t = t_, d = t & 127, i0 = t >> 7;
    const bf16* Z = (const bf16*)(F.ws + WS_Z) + (size_t)rowb * NIN;
    const float* rope = (const float*)(F.ws + WS_ROPE);
    const float lg = logf(1.f - exp2f(-5.f - (float)h));
    bf16* QT = (bf16*)(F.ws + WS_QT) + QT_R + (size_t)ci * 64 * 256;
    bf16* KT = (bf16*)(F.ws + WS_KT) + QT_R + (size_t)ci * 256 * 64;
    bf16* Pm = (bf16*)(F.ws + WS_P) + P_R + (size_t)ci * 4096;
    stage_tile<256>(F.lds + RR_RAWQ, Z + ZQ_R + h * 256, t);
    stage_tile<256>(F.lds + RR_RAWK, Z + ZK_R + h * 256, t);
    __syncthreads();
    float k0v[16], k1v[16];
#pragma unroll
    for (int hf = 0; hf < 4; ++hf) {
        unsigned short r1[4], r2[4], r3[4], r4[4]; f32x2 rc[4];
#pragma unroll
        for (int i8 = 0; i8 < 4; ++i8) { const int i = 16 * i0 + 4 * hf + i8; int pos = c * 64 + i - 48; pos = pos < 0 ? 0 : pos;
            const LAS unsigned short* rq_ = (const LAS unsigned short*)(F.lds + RR_RAWQ) + i * 256 + d; const LAS unsigned short* rk_ = (const LAS unsigned short*)(F.lds + RR_RAWK) + i * 256 + d;
            rc[i8] = *(const GAS f32x2*)(rope + ((size_t)pos * 128 + d) * 2); r1[i8] = rq_[0]; r2[i8] = rq_[128]; r3[i8] = rk_[0]; r4[i8] = rk_[128]; }
        __builtin_amdgcn_sched_barrier(0);
#pragma unroll
        for (int i8 = 0; i8 < 4; ++i8) { const int ii = 4 * hf + i8, i = 16 * i0 + ii; const f32x2 csn = rc[i8];
            const float q1 = bf2f(r1[i8]), q2 = bf2f(r2[i8]), k1 = bf2f(r3[i8]), k2 = bf2f(r4[i8]);
            const float rq0 = q1 * csn.x - q2 * csn.y, rq1 = q1 * csn.y + q2 * csn.x, rk0 = k1 * csn.x - k2 * csn.y, rk1 = k1 * csn.y + k2 * csn.x;
            QR[i * 264 + d] = f2bf(rq0); QR[i * 264 + 128 + d] = f2bf(rq1); KR[i * 264 + d] = f2bf(rk0); KR[i * 264 + 128 + d] = f2bf(rk1);
            const float gq = __expf((float)(i + 1) * lg), gk = __expf((float)(63 - i) * lg);
            ((GAS bf16*)QT)[i * 256 + d] = f2bf(rq0 * gq); ((GAS bf16*)QT)[i * 256 + 128 + d] = f2bf(rq1 * gq); k0v[ii] = rk0 * gk; k1v[ii] = rk1 * gk; }
        __builtin_amdgcn_sched_barrier(0);
    }
    { unsigned w0[8], w1[8];
#pragma unroll
      for (int jj = 0; jj < 8; ++jj) { w0[jj] = cvtpk(k0v[2 * jj], k0v[2 * jj + 1]); w1[jj] = cvtpk(k1v[2 * jj], k1v[2 * jj + 1]); }
      GAS u32x4* dst = (GAS u32x4*)(KT + (size_t)d * 64 + 16 * i0); dst[0] = (u32x4){w0[0], w0[1], w0[2], w0[3]}; dst[1] = (u32x4){w0[4], w0[5], w0[6], w0[7]};
      dst = (GAS u32x4*)(KT + (size_t)(d + 128) * 64 + 16 * i0); dst[0] = (u32x4){w1[0], w1[1], w1[2], w1[3]}; dst[1] = (u32x4){w1[4], w1[5], w1[6], w1[7]}; }
    __syncthreads();
    stage_tile<256>(F.lds + RR_RAWQ, Z + ZV_R + h * 256, t);
    { const int w = F.wave, r = F.lane & 15, q = F.lane >> 4;
#pragma unroll
      for (int tt = 0; tt < 2; ++tt) { const int T = w + 8 * tt, ti = T >> 2, tj = T & 3; f32x4 acc = (f32x4){0.f, 0.f, 0.f, 0.f};
          if (tj <= ti) { const LAS unsigned char* qa = F.lds + RR_Q + (16 * ti + r) * 528 + 16 * q; const LAS unsigned char* kb = F.lds + RR_K + (16 * tj + r) * 528 + 16 * q;
              __builtin_amdgcn_s_setprio(1);
#pragma unroll
              for (int k = 0; k < 8; ++k) acc = __builtin_amdgcn_mfma_f32_16x16x32_bf16(*(const LAS bf16x8*)(kb + 64 * k), *(const LAS bf16x8*)(qa + 64 * k), acc, 0, 0, 0);
              __builtin_amdgcn_s_setprio(0); }
          const int i = 16 * ti + r, j0 = 16 * tj + 4 * q; float pv[4];
#pragma unroll
          for (int jj = 0; jj < 4; ++jj) pv[jj] = (j0 + jj <= i) ? acc[jj] * __expf((float)(i - j0 - jj) * lg) : 0.f;
          u32x2 pw; pw.x = cvtpk(pv[0], pv[1]); pw.y = cvtpk(pv[2], pv[3]);
          *(GAS u32x2*)(Pm + i * 64 + j0) = pw; } }
    __syncthreads();
    write_vT_lds<256>(t, (const LAS unsigned short*)(F.lds + RR_RAWQ), (bf16*)(F.ws + WS_VT) + VT_R + (size_t)ci * 256 * 64, false);
    __syncthreads();
}

template <bool CONSTLAM, bool USEP>
__device__ __forceinline__ void scan_item(Frame& F, const bf16* QT, int QLD, size_t qci, const bf16* KT, size_t kci, const bf16* VT, size_t vci, const bf16* Pm, const float* LAM, float lamc,
                                          bf16* O, int OLD, int ocol, int H, int h, int b) {
    constexpr int DK = 128, QS = DK * 2 + 16, RS = 144;
    constexpr int OFF_Q = 0, OFF_K = OFF_Q + 64 * QS, OFF_V = OFF_K + DK * RS, OFF_P = OFF_V + 128 * RS, OFF_L = OFF_P + 64 * RS;
    LAS unsigned char* lds = F.lds;
    const int t = F.tid, w = F.wave, r = F.lane & 15, q = F.lane >> 4;
    float zs = 0.f; asm volatile("" : "+v"(zs));
    f32x4 S[DK / 16];
#pragma unroll
    for (int i = 0; i < DK / 16; ++i) S[i] = (f32x4){zs, zs, zs, zs};
    f32x4 rlA = (f32x4){zs, zs, zs, zs}, rlB = rlA; u32x4 rqA[2], rkA[2], rvA[2], rqB[2], rkB[2], rvB[2], rpA = __builtin_bit_cast(u32x4, rlA), rpB = rpA;
    const unsigned qob0 = (unsigned)((t >> 4) * QLD + (t & 15) * 8) * 2u, qob1 = (unsigned)(((t + 512) >> 4) * QLD + (t & 15) * 8) * 2u, lob = (unsigned)t * 16u;
#define SCAN_LOAD(cc, rq, rk, rv, rp, rl) do { \
        const size_t ci_ = (size_t)(b * NCH + (cc)) * H + h; \
        const char* gq_ = (const char*)(QT + ci_ * qci); const char* gk_ = (const char*)(KT + ci_ * kci); const char* gv_ = (const char*)(VT + ci_ * vci); \
        rq[0] = *(const GAS u32x4*)(gq_ + qob0); rq[1] = *(const GAS u32x4*)(gq_ + qob1); \
        rk[0] = *(const GAS u32x4*)(gk_ + lob); rk[1] = *(const GAS u32x4*)(gk_ + lob + 8192u); \
        rv[0] = *(const GAS u32x4*)(gv_ + lob); rv[1] = *(const GAS u32x4*)(gv_ + lob + 8192u); \
        if (USEP) rp = *(const GAS u32x4*)((const char*)(Pm + ci_ * 4096) + lob); \
        if (!CONSTLAM) { if (t < DK / 4) rl = *(const GAS f32x4*)((const char*)(LAM + ci_ * DK) + lob); } \
    } while (0)
#define SCAN_PUT(base, rq, rk, rv, rp, rl) do { \
        _Pragma("unroll") for (int i_ = 0; i_ < 2; ++i_) { const int idx_ = t + 512 * i_; \
            *(LAS u32x4*)((base) + OFF_Q + (idx_ >> 4) * QS + (idx_ & 15) * 16) = rq[i_]; \
            *(LAS u32x4*)((base) + OFF_K + (idx_ >> 3) * RS + (idx_ & 7) * 16) = rk[i_]; \
            *(LAS u32x4*)((base) + OFF_V + (idx_ >> 3) * RS + (idx_ & 7) * 16) = rv[i_]; } \
        if (USEP) *(LAS u32x4*)((base) + OFF_P + (t >> 3) * RS + (t & 7) * 16) = rp; \
        if (!CONSTLAM) { if (t < DK / 4) *(LAS f32x4*)((base) + OFF_L + t * 16) = rl; } \
    } while (0)
    constexpr int BUFB = 65536;
    SCAN_LOAD(0, rqA, rkA, rvA, rpA, rlA);
    SCAN_LOAD(1, rqB, rkB, rvB, rpB, rlB);
    SCAN_PUT(lds, rqA, rkA, rvA, rpA, rlA);
    SCAN_LOAD(2, rqA, rkA, rvA, rpA, rlA);
    __syncthreads();
    for (int c2 = 0; c2 < NCH; c2 += 2) {
#pragma unroll
      for (int ph_ = 0; ph_ < 2; ++ph_) {
        const int c = c2 + ph_;
        if (c < NCH) {
        LAS unsigned char* const ldc = lds + ph_ * BUFB;
        bf16x8 vf[2];
#pragma unroll
        for (int jt = 0; jt < 2; ++jt) vf[jt] = *(const LAS bf16x8*)(ldc + OFF_V + (16 * w + r) * RS + (32 * jt + 8 * q) * 2);
        f32x4 o[4];
#pragma unroll
        for (int it = 0; it < 4; ++it) o[it] = (f32x4){0.f, 0.f, 0.f, 0.f};
#pragma unroll
        for (int kb = 0; kb < 2; ++kb) {
            u32x2 qlo[2][4], qhi[2][4];
#pragma unroll
            for (int k2 = 0; k2 < 2; ++k2)
#pragma unroll
                for (int it = 0; it < 4; ++it) { const int k = 2 * kb + k2; qlo[k2][it] = *(const LAS u32x2*)(ldc + OFF_Q + (16 * it + r) * QS + (32 * k + 4 * q) * 2); qhi[k2][it] = *(const LAS u32x2*)(ldc + OFF_Q + (16 * it + r) * QS + (32 * k + 16 + 4 * q) * 2); }
            bf16x8 sf[2];
#pragma unroll
            for (int k2 = 0; k2 < 2; ++k2) { const int k = 2 * kb + k2; u32x4 p; p.x = cvtpk(S[2 * k][0], S[2 * k][1]); p.y = cvtpk(S[2 * k][2], S[2 * k][3]); p.z = cvtpk(S[2 * k + 1][0], S[2 * k + 1][1]); p.w = cvtpk(S[2 * k + 1][2], S[2 * k + 1][3]); sf[k2] = __builtin_bit_cast(bf16x8, p); }
            __builtin_amdgcn_sched_barrier(0); __builtin_amdgcn_s_setprio(1);
#pragma unroll
            for (int k2 = 0; k2 < 2; ++k2)
#pragma unroll
                for (int it = 0; it < 4; ++it) o[it] = __builtin_amdgcn_mfma_f32_16x16x32_bf16(sf[k2], __builtin_bit_cast(bf16x8, ((u32x4){qlo[k2][it].x, qlo[k2][it].y, qhi[k2][it].x, qhi[k2][it].y})), o[it], 0, 0, 0);
            __builtin_amdgcn_s_setprio(0); __builtin_amdgcn_sched_barrier(0);
        }
        bf16* orow = O + (size_t)(b * LP + c * 64 + r) * OLD + ocol + 16 * w + 4 * q;
        if (USEP) {
            bf16x8 pf[4][2];
#pragma unroll
            for (int it = 0; it < 4; ++it)
#pragma unroll
                for (int jt = 0; jt < 2; ++jt) pf[it][jt] = *(const LAS bf16x8*)(ldc + OFF_P + (16 * it + r) * RS + (32 * jt + 8 * q) * 2);
            __builtin_amdgcn_sched_barrier(0);
#pragma unroll
            for (int jt = 0; jt < 2; ++jt)
#pragma unroll
                for (int it = 0; it < 4; ++it) o[it] = __builtin_amdgcn_mfma_f32_16x16x32_bf16(vf[jt], pf[it][jt], o[it], 0, 0, 0);
        }
#pragma unroll
        for (int it = 0; it < 4; ++it) { u32x2 pw; pw.x = cvtpk(o[it][0], o[it][1]); pw.y = cvtpk(o[it][2], o[it][3]); *(GAS u32x2*)(orow + (size_t)(16 * it) * OLD) = pw; }
        __builtin_amdgcn_sched_barrier(0);
#pragma unroll
        for (int hb = 0; hb < 2; ++hb) {
            bf16x8 kf[4][2];
#pragma unroll
            for (int d4 = 0; d4 < 4; ++d4)
#pragma unroll
                for (int jt = 0; jt < 2; ++jt) kf[d4][jt] = *(const LAS bf16x8*)(ldc + OFF_K + (16 * (4 * hb + d4) + r) * RS + (32 * jt + 8 * q) * 2);
            f32x4 lam[4];
#pragma unroll
            for (int d4 = 0; d4 < 4; ++d4) { if (CONSTLAM) lam[d4] = (f32x4){lamc, lamc, lamc, lamc}; else lam[d4] = *(const LAS f32x4*)(ldc + OFF_L + (16 * (4 * hb + d4) + 4 * q) * 4); }
            __builtin_amdgcn_sched_barrier(0); __builtin_amdgcn_s_setprio(1);
#pragma unroll
            for (int d4 = 0; d4 < 4; ++d4) S[4 * hb + d4] = S[4 * hb + d4] * lam[d4];
#pragma unroll
            for (int jt = 0; jt < 2; ++jt)
#pragma unroll
                for (int d4 = 0; d4 < 4; ++d4) S[4 * hb + d4] = __builtin_amdgcn_mfma_f32_16x16x32_bf16(kf[d4][jt], vf[jt], S[4 * hb + d4], 0, 0, 0);
            __builtin_amdgcn_s_setprio(0); __builtin_amdgcn_sched_barrier(0);
        }
        if (c + 1 < NCH) {
            if (ph_ == 0) { SCAN_PUT(lds + BUFB, rqB, rkB, rvB, rpB, rlB); if (c + 3 < NCH) SCAN_LOAD(c + 3, rqB, rkB, rvB, rpB, rlB); }
            else { SCAN_PUT(lds, rqA, rkA, rvA, rpA, rlA); if (c + 3 < NCH) SCAN_LOAD(c + 3, rqA, rkA, rvA, rpA, rlA); }
        }
        __syncthreads();
        }
      }
    }
#undef SCAN_PUT
#undef SCAN_LOAD
}

constexpr int N_SCAN_ITEMS = 64;
__device__ __forceinline__ void scan_phase(Frame& F, int L) {
    const bf16* QT = (const bf16*)(F.ws + WS_QT); const bf16* KT = (const bf16*)(F.ws + WS_KT); const bf16* VT = (const bf16*)(F.ws + WS_VT); const bf16* Pm = (const bf16*)(F.ws + WS_P);
    bf16* O = (bf16*)(F.ws + WS_O); bf16* O2 = (bf16*)(F.ws + WS_O2);
    if (F.G > N_SCAN_ITEMS && F.bid >= N_SCAN_ITEMS) {
        const int gw = (F.bid - N_SCAN_ITEMS) * 8 + F.wave, NGW = (F.G - N_SCAN_ITEMS) * 8;
        for (int j = 0; j < (L == 0 ? 2 : 1); ++j) convert_range(F, j == 0 ? L : 1, j == 0 ? CI_PARTA : 0, j == 0 ? CI_ALL : CI_PARTA, gw, NGW);
        return;
    }
    for (int item = F.bid; item < N_SCAN_ITEMS; item += F.G) {
        if (item < 16) { const int es = item & 1, h = (item >> 1) & 3, b = item >> 3;
            scan_item<false, true>(F, QT + QT_G, 128, 64 * 128, KT + QT_G, 128 * 64, VT + VT_G + (size_t)es * 128 * 64, 256 * 64, Pm + P_G, (const float*)(F.ws + WS_LAMG), 0.f, O, 3072, 0 + h * 256 + es * 128, 4, h, b);
        } else if (item < 48) { const int it = item - 16, dh = it & 1, es = (it >> 1) & 1, h = (it >> 2) & 3, b = it >> 4;
            const float lamc = __expf(64.f * logf(1.f - exp2f(-5.f - (float)h)));
            if (dh == 0) scan_item<true, true>(F, QT + QT_R, 256, 64 * 256, KT + QT_R, 256 * 64, VT + VT_R + (size_t)es * 128 * 64, 256 * 64, Pm + P_R, nullptr, lamc, O, 3072, 1024 + h * 256 + es * 128, 4, h, b);
            else scan_item<true, false>(F, QT + QT_R + 128, 256, 64 * 256, KT + QT_R + (size_t)128 * 64, 256 * 64, VT + VT_R + (size_t)es * 128 * 64, 256 * 64, Pm + P_R, nullptr, lamc, O2, 1024, h * 256 + es * 128, 4, h, b);
        } else { const int it = item - 48, h = it & 7, b = it >> 3;
            scan_item<false, true>(F, QT + QT_H, 128, 64 * 128, KT + QT_H, 128 * 64, VT + VT_H, 128 * 64, Pm + P_H, (const float*)(F.ws + WS_LAMH), 0.f, O, 3072, 2048 + h * 128, 8, h, b);
        }
    }
}

__device__ __forceinline__ void normgate_phase(Frame& F, int L) {
    const int gw = F.vcu * 8 + F.wave, NGW = F.G * 8, lane = F.lane;
    const bf16* O = (const bf16*)(F.ws + WS_O); const bf16* O2 = (const bf16*)(F.ws + WS_O2); const bf16* Z = (const bf16*)(F.ws + WS_Z); bf16* YS = (bf16*)(F.ws + WS_YS);
    for (int r = gw; r < MR; r += NGW) {
#pragma unroll
        for (int br = 0; br < 3; ++br) {
            const float* gain = F.in[br == 0 ? 10 : (br == 1 ? 11 : 13)] + (size_t)L * 1024;
            const int zg = br == 0 ? ZG_G : (br == 1 ? ZG_R : ZG_H);
#pragma unroll
            for (int hh = 0; hh < 4; ++hh) { const int col = hh * 256 + 4 * lane;
                const u32x2 pa = *(const GAS u32x2*)(O + (size_t)r * 3072 + br * 1024 + col);
                f32x4 v = (f32x4){bflo(pa.x), bfhi(pa.x), bflo(pa.y), bfhi(pa.y)};
                if (br == 1) { const u32x2 pb = *(const GAS u32x2*)(O2 + (size_t)r * 1024 + col); v = v + (f32x4){bflo(pb.x), bfhi(pb.x), bflo(pb.y), bfhi(pb.y)}; }
                if (br == 1) { const float mean = wave_sum((v[0] + v[1]) + (v[2] + v[3])) * (1.f / 256.f); v = v - mean; }
                float ss = (v[0] * v[0] + v[1] * v[1]) + (v[2] * v[2] + v[3] * v[3]);
                if (br == 2) {
#pragma unroll
                    for (int o = 1; o < 32; o <<= 1) ss += __shfl_xor(ss, o);
                    ss *= (1.f / 128.f);
                } else ss = wave_sum(ss) * (1.f / 256.f);
                const float rs = rsqrtf(ss + EPS);
                const f32x4 gn = *(const GAS f32x4*)(gain + col); const u32x2 gz = *(const GAS u32x2*)(Z + (size_t)r * NIN + zg + col);
                const float y0 = v[0] * rs * gn[0] * silu_f(bflo(gz.x)), y1 = v[1] * rs * gn[1] * silu_f(bfhi(gz.x)), y2 = v[2] * rs * gn[2] * silu_f(bflo(gz.y)), y3 = v[3] * rs * gn[3] * silu_f(bfhi(gz.y));
                u32x2 w; w.x = cvtpk(y0, y1); w.y = cvtpk(y2, y3); *(GAS u32x2*)(YS + (size_t)r * 3072 + br * 1024 + col) = w; }
        }
    }
}

__device__ __forceinline__ void final_phase(Frame& F, float* out) {
    const int gw = F.vcu * 8 + F.wave, NGW = F.G * 8, lane = F.lane;
    const float* H = (const float*)(F.ws + WS_H); const u64* ssq = (const u64*)(F.ws + WS_SSQ) + (size_t)6 * MP; const float* gain = F.in[20];
    for (int o = gw; o < NBATCH * SEQ; o += NGW) { const int b = o / SEQ, s = o % SEQ, r = b * LP + 64 + s; const float rs = rsqrtf(ssq_get(ssq, r) * (1.f / D) + EPS);
#pragma unroll
        for (int j = 0; j < 8; ++j) { const f32x4 v = ((const GAS f32x4*)(H + (size_t)r * D))[lane + 64 * j], gn = ((const GAS f32x4*)gain)[lane + 64 * j]; ((GAS f32x4*)(out + (size_t)o * D))[lane + 64 * j] = v * rs * gn; } }
}

#define XB_TMO      128
#define XB_XCNT(j)  (256  + 64 * (j))
#define XB_XSUB(j)  (1280 + 64 * (j))
#define XB_XGEN(j)  (2304 + 64 * (j))
#define XB_TOP      3328
#define XB_TOPGEN   3392
#define XCD_BAR_WORDS 3456
#define XB_SPIN_CAP (1u << 18)

__device__ __forceinline__ unsigned xb_ld(unsigned* p)              { return __hip_atomic_load(p, __ATOMIC_RELAXED, __HIP_MEMORY_SCOPE_AGENT); }
__device__ __forceinline__ unsigned xb_add(unsigned* p, unsigned v) { return __hip_atomic_fetch_add(p, v, __ATOMIC_RELAXED, __HIP_MEMORY_SCOPE_AGENT); }
__device__ __forceinline__ unsigned xb_xcc_id() { return (unsigned)__builtin_amdgcn_s_getreg((3 << 11) | 20) & 0xFu; }
#define XB_SPIN(cond, bar) do { unsigned _sp = 0; while (cond) { __builtin_amdgcn_s_sleep(1); \
    if ((++_sp & 255u) == 0u) { if (xb_ld(&(bar)[XB_TMO])) break; if (_sp > XB_SPIN_CAP) { atomicAdd(&(bar)[XB_TMO], 1u); break; } } } } while (0)

struct XcdBarrier {
    unsigned* bar; unsigned x;
    volatile LAS unsigned* st;
};

__device__ __forceinline__ XcdBarrier xcd_barrier_post(unsigned* bar, volatile LAS unsigned* st) {
    XcdBarrier b; b.bar = bar; b.x = xb_xcc_id(); b.st = st;
    if (threadIdx.x == 0) (void)xb_add(&bar[XB_XCNT(b.x)], 1u);
    return b;
}
__device__ __forceinline__ void xcd_barrier_complete(unsigned* bar, unsigned x, unsigned& nloc, unsigned& nx) {
    const unsigned G = gridDim.x * gridDim.y * gridDim.z;
    unsigned sum, cnt, mine, sp = 0u;
    for (;;) {
        sum = 0u; cnt = 0u; mine = 0u;
#pragma unroll
        for (unsigned j = 0; j < 16; ++j) { const unsigned c = xb_ld(&bar[XB_XCNT(j)]); sum += c; cnt += (c > 0u) ? 1u : 0u; mine = (j == x) ? c : mine; }
        if (sum == G) break;
        __builtin_amdgcn_s_sleep(1);
        if ((++sp & 255u) == 0u) { if (xb_ld(&bar[XB_TMO])) break; if (sp > XB_SPIN_CAP) { atomicAdd(&bar[XB_TMO], 1u); break; } }
    }
    nloc = mine > 0u ? mine : 1u; nx = cnt > 0u ? cnt : 1u;
}

__device__ __forceinline__ void xcd_barrier(const XcdBarrier& b) {
    asm volatile("s_waitcnt vmcnt(0)" ::: "memory");
    __syncthreads();
    if (threadIdx.x == 0) {
        unsigned* bar = b.bar;
        __builtin_amdgcn_s_waitcnt(0);
        unsigned nloc = b.st[0], nx = b.st[1];
        if (nloc == 0u) { xcd_barrier_complete(bar, b.x, nloc, nx); b.st[0] = nloc; b.st[1] = nx; }
        const unsigned old = xb_add(&bar[XB_XSUB(b.x)], 1u);
        const unsigned gen = old / nloc;
        if (old + 1u == (gen + 1u) * nloc) {
            __builtin_amdgcn_fence(__ATOMIC_RELEASE, "agent");
            asm volatile("s_waitcnt vmcnt(0)" ::: "memory");
            const unsigned og = xb_add(&bar[XB_TOP], 1u);
            const unsigned tg = og / nx;
            if (og + 1u == (tg + 1u) * nx) xb_add(&bar[XB_TOPGEN], 1u);
            else XB_SPIN(xb_ld(&bar[XB_TOPGEN]) == tg, bar);
            __builtin_amdgcn_fence(__ATOMIC_ACQUIRE, "agent");
            xb_add(&bar[XB_XGEN(b.x)], 1u);
            asm volatile("s_waitcnt vmcnt(0)" ::: "memory");
        } else {
            XB_SPIN(xb_ld(&bar[XB_XGEN(b.x)]) == gen, bar);
            __builtin_amdgcn_fence(__ATOMIC_ACQUIRE, "agent");
            asm volatile("s_waitcnt vmcnt(0)" ::: "memory");
        }
    }
    __syncthreads();
}


__global__ void __launch_bounds__(512, 2) trunk_fwd(Args args) {
    extern __shared__ __attribute__((aligned(16))) unsigned char lds_raw[];
    Frame F;
    F.lds = (LAS unsigned char*)lds_raw;
    if (threadIdx.x == 0) { volatile LAS unsigned* st_ = (volatile LAS unsigned*)((LAS unsigned char*)lds_raw + 147328); st_[0] = 0u; st_[1] = 0u; }
    if (args.ph_hi - args.ph_lo > 1) {
        if (blockIdx.x == 0) { for (int i_ = threadIdx.x; i_ < XCD_BAR_WORDS; i_ += 512) ((unsigned*)(args.ws + WS_BAR))[i_] = 0u; }
        __syncthreads(); cg::this_grid().sync();
        (void)xcd_barrier_post((unsigned*)(args.ws + WS_BAR), (volatile LAS unsigned*)((LAS unsigned char*)lds_raw + 147328));
    }
#if REPEAT_KIND >= 0
    for (int ph2 = 2 * args.ph_lo; ph2 < 2 * args.ph_hi; ++ph2) {
        const int ph = ph2 >> 1;
        { int k_ = ph == 0 ? 0 : (ph <= 10 ? ph : (ph <= 20 ? ph - 10 : 12));
          const bool rpt = (k_ == REPEAT_KIND) || (REPEAT_KIND == 1 && k_ == 9) || (REPEAT_KIND == 0 && k_ == 11);
          if ((ph2 & 1) && !rpt) continue; }
#else
    for (int ph = args.ph_lo; ph < args.ph_hi; ++ph) {
#endif
        unsigned char* ws = args.ws; asm volatile("" : "+s"(ws));
        int tid_ = threadIdx.x; asm volatile("" : "+v"(tid_));
        int bid = blockIdx.x; asm volatile("" : "+s"(bid));
        int G_ = gridDim.x; asm volatile("" : "+s"(G_)); F.G = G_;
        int zero_ = 0; asm volatile("" : "+s"(zero_)); F.in = args.in + zero_;
        F.ws = ws; F.tid = tid_; F.lane = tid_ & 63; F.wave = __builtin_amdgcn_readfirstlane(tid_ >> 6); F.bid = bid;
        F.vcu = (F.G % 8 == 0) ? (bid % 8) * (F.G / 8) + bid / 8 : bid;
        u64* ssq = (u64*)(ws + WS_SSQ);
        bf16* HB = (bf16*)(ws + WS_HB); float* Hf = (float*)(ws + WS_H); bf16* Zb = (bf16*)(ws + WS_Z); bf16* ACT = Zb;
        int L = 0, kind;
        if (ph == 0) kind = 0; else if (ph <= 10) kind = ph; else if (ph <= 20) { kind = ph - 10; L = 1; } else kind = 12;
        if (kind == 0) { if (KEN(0)) { init_phase(F); convert_range(F, 0, 0, CI_PARTA, F.vcu * 8 + F.wave, F.G * 8); } }
        else if (KEN(1) && (kind == 1 || kind == 9)) {
            pg8::Gemm g{HB, (const bf16*)(ws + WS_W + (kind == 1 ? W_GU1 : W_GU2)), D, D, D, 0, 0, 1, 0}; { pg8::MainRounds S; S.init(8192, NGU, F.G, F.bid, D);
              pg8::EpiGateUpT<false> E{ACT, ssq + (size_t)(3 * L + (kind == 1 ? 0 : 2)) * MP};
              pg8::gemm_phase<pg8::EpiGateUpT<false>, pg8::MainRounds>(F.lds, g, S, E, F.tid); }
            { pg8::TailHalves S; S.init(8192, NGU, F.G, F.bid, D);
              pg8::EpiGateUpT<true> E{ACT, ssq + (size_t)(3 * L + (kind == 1 ? 0 : 2)) * MP};
              pg8::gemm_phase<pg8::EpiGateUpT<true>, pg8::TailHalves>(F.lds, g, S, E, F.tid); }
        } else if (KEN(2) && (kind == 2 || kind == 10)) {
            const bf16* Wd = (const bf16*)(ws + WS_W + (kind == 2 ? W_D1 : W_D2)); const int si = 3 * L + (kind == 2 ? 1 : 3);
            { pg8::Gemm g{ACT, Wd, FF, FF, FF, 512, 512, 1 << 30, 0}; pg8::SplitOrder S; S.init(32, D, FF, 1, F.G, F.bid);
              pg8::EpiSplitStore E{ws, ph * 8};
              pg8::gemm_phase<pg8::EpiSplitStore, pg8::SplitOrder>(F.lds, g, S, E, F.tid); }
            { pg8::Gemm g{ACT, Wd, FF, FF, FF, 0, 0, 1, 0}; pg8::StaticOrder S; S.init(8192, D, F.G, F.bid, 1, FF);
              pg8::EpiResid E{(L == 1 && kind == 10) ? Hf : nullptr, HB, ssq + (size_t)si * MP, 0.5f};
              pg8::gemm_phase<pg8::EpiResid, pg8::StaticOrder>(F.lds, g, S, E, F.tid); }
            pg8::split_finish_resid(ws, si, 0.5f, ph * 8, FF / 256, 32, F.bid, F.tid, L == 1 && kind == 10);
        } else if (KEN(3) && kind == 3) {
            pg8::Gemm g{HB, (const bf16*)(ws + WS_W + W_IN), D, D, D, 0, 0, 1, 0}; pg8::StaticOrder S; S.init(MP, NIN, F.G, F.bid, 1, D);
            pg8::EpiRowScale E{Zb, NIN, ssq + (size_t)(3 * L + 1) * MP};
            pg8::gemm_phase<pg8::EpiRowScale, pg8::StaticOrder>(F.lds, g, S, E, F.tid);
        } else if (KEN(4) && kind == 4) {
            for (int it = F.bid; it < 2080; it += F.G) { if (it < 520) prep_gh<0>(F, L, it); else if (it < 1040) prep_ret(F, it - 520); else prep_gh<2>(F, L, it - 1040); }
        } else if (KEN(5) && kind == 5) { scan_phase(F, L); }
        else if (KEN(6) && kind == 6) { normgate_phase(F, L); }
        else if (KEN(7) && kind == 7) {
            { pg8::Gemm g{(const bf16*)(ws + WS_YS), (const bf16*)(ws + WS_W + W_B), 3072, 1024, 1024, 512, 512, 4, (size_t)D * 1024 * 2}; pg8::SplitOrder S; S.init(32, D, 1024, 3, F.G, F.bid);
              pg8::EpiSplitStore E{ws, ph * 8};
              pg8::gemm_phase<pg8::EpiSplitStore, pg8::SplitOrder>(F.lds, g, S, E, F.tid); }
            { pg8::Gemm g{(const bf16*)(ws + WS_YS), (const bf16*)(ws + WS_W + W_B), 3072, 1024, 1024, (size_t)1024 * 2, 0, 1, (size_t)D * 1024 * 2}; pg8::StaticOrder S; S.init(8192, D, F.G, F.bid, 3, 1024);
              pg8::EpiBranch E{Zb, (bf16*)(ws + WS_MB)};
              pg8::gemm_phase<pg8::EpiBranch, pg8::StaticOrder>(F.lds, g, S, E, F.tid); }
            pg8::split_finish_branch(ws, ph * 8, 4, 32, F.bid, F.tid);
        } else if (KEN(8) && kind == 8) {
            { pg8::Gemm g{(const bf16*)(ws + WS_MB), (const bf16*)(ws + WS_W + W_O), D, D, D, 512, 512, 1 << 30, 0}; pg8::SplitOrder S; S.init(32, D, D, 1, F.G, F.bid);
              pg8::EpiSplitStore E{ws, ph * 8};
              pg8::gemm_phase<pg8::EpiSplitStore, pg8::SplitOrder>(F.lds, g, S, E, F.tid); }
            { pg8::Gemm g{(const bf16*)(ws + WS_MB), (const bf16*)(ws + WS_W + W_O), D, D, D, 0, 0, 1, 0}; pg8::StaticOrder S; S.init(8192, D, F.G, F.bid, 1, D);
              pg8::EpiResid E{nullptr, HB, ssq + (size_t)(3 * L + 2) * MP, 1.0f};
              pg8::gemm_phase<pg8::EpiResid, pg8::StaticOrder>(F.lds, g, S, E, F.tid); }
            pg8::split_finish_resid(ws, 3 * L + 2, 1.0f, ph * 8, D / 256, 32, F.bid, F.tid, false);
        } else if (KEN(12) && kind == 12) { final_phase(F, args.out); }
        if (ph + 1 < args.ph_hi) {
            volatile LAS unsigned* st_ = (volatile LAS unsigned*)((LAS unsigned char*)lds_raw + 147328);
            { XcdBarrier xb_; xb_.bar = (unsigned*)(ws + WS_BAR); xb_.x = xb_xcc_id(); xb_.st = st_; xcd_barrier(xb_); }
        }
    }
}

extern "C" void kernel_launch(void* const* d_in, const int* in_sizes, int n_in, void* d_out, int out_size, void* d_ws, size_t ws_size, hipStream_t stream) {
    static int grid = 0;
    if (grid == 0) {
        if (n_in != 21 || out_size != NBATCH * SEQ * D || ws_size < WS_END) { fprintf(stderr, "kernel_launch: unexpected shapes (n_in %d out %d ws %zu need %zu)\n", n_in, out_size, ws_size, (size_t)WS_END); grid = -1; return; }
        int dev = 0, cus = 0;
        if (hipGetDevice(&dev) != hipSuccess || hipDeviceGetAttribute(&cus, hipDeviceAttributeMultiprocessorCount, dev) != hipSuccess) { grid = -1; return; }
        if (hipFuncSetAttribute((const void*)trunk_fwd, hipFuncAttributeMaxDynamicSharedMemorySize, LDS_BYTES) != hipSuccess) { fprintf(stderr, "kernel_launch: hipFuncSetAttribute failed\n"); grid = -1; return; }
        int per_cu = 0;
        if (hipOccupancyMaxActiveBlocksPerMultiprocessor(&per_cu, (const void*)trunk_fwd, 512, LDS_BYTES) != hipSuccess || per_cu < 1) { fprintf(stderr, "kernel_launch: occupancy query says %d\n", per_cu); }
        (void)hipGetLastError();
        grid = cus;
    }
    if (grid < 0) return;
    Args a{};
    for (int i = 0; i < 21; ++i) a.in[i] = (const float*)d_in[i];
    a.out = (float*)d_out; a.ws = (unsigned char*)d_ws;
#if ONE_LAUNCH
    a.ph_lo = 0; a.ph_hi = NPHASE;
    void* kargs[] = {&a};
    hipError_t e = hipLaunchCooperativeKernel((const void*)trunk_fwd, dim3(grid), dim3(512), kargs, LDS_BYTES, stream);
    if (e != hipSuccess) fprintf(stderr, "cooperative launch failed: %s (grid %d)\n", hipGetErrorString(e), grid);
#else
    for (int ph = 0; ph < NPHASE; ++ph) { a.ph_lo = ph; a.ph_hi = ph + 1; hipLaunchKernelGGL(trunk_fwd, dim3(grid), dim3(512), LDS_BYTES, stream, a); }
#endif
}
```

```cpp
#include <hip/hip_runtime.h>
#include <hip/hip_cooperative_groups.h>
#include <cstdio>
#include <cstdint>
namespace cg = cooperative_groups;

#ifndef ONE_LAUNCH
#define ONE_LAUNCH 1
#endif
#ifndef ONLY_KIND
#define ONLY_KIND -1
#endif
#define KEN(k) (ONLY_KIND < 0 || ONLY_KIND == (k))
#ifndef REPEAT_KIND
#define REPEAT_KIND -1
#endif

#define LAS __attribute__((address_space(3)))
#define GAS __attribute__((address_space(1)))
typedef unsigned short bf16;
typedef short bf16x8 __attribute__((ext_vector_type(8)));
typedef float f32x4 __attribute__((ext_vector_type(4)));
typedef float f32x2 __attribute__((ext_vector_type(2)));
typedef unsigned u32x4 __attribute__((ext_vector_type(4)));
typedef unsigned u32x2 __attribute__((ext_vector_type(2)));
typedef __bf16 bf16x2_t __attribute__((ext_vector_type(2)));

__device__ __forceinline__ unsigned cvtpk(float lo, float hi) { f32x2 v = {lo, hi}; bf16x2_t b = __builtin_convertvector(v, bf16x2_t); return __builtin_bit_cast(unsigned, b); }
__device__ __forceinline__ unsigned short f2bf(float f) { return (unsigned short)(cvtpk(f, 0.f) & 0xffffu); }
__device__ __forceinline__ float bf2f(unsigned short v) { return __uint_as_float((unsigned)v << 16); }
__device__ __forceinline__ float bflo(unsigned w) { return __uint_as_float(w << 16); }
__device__ __forceinline__ float bfhi(unsigned w) { return __uint_as_float(w & 0xffff0000u); }
typedef unsigned long long u64;
constexpr float SSQ_SCALE = 16777216.f;
__device__ __forceinline__ float ssq_get(const u64* p, int row) { return (float)p[row] * (1.f / SSQ_SCALE); }
__device__ __forceinline__ u64 ssq_fix(float s) { return (u64)(s * SSQ_SCALE + 0.5f); }
__device__ __forceinline__ float silu_f(float x) { return x * __builtin_amdgcn_rcpf(1.f + __expf(-x)); }
__device__ __forceinline__ float sigmoid_f(float x) { return __builtin_amdgcn_rcpf(1.f + __expf(-x)); }

constexpr int D = 2048, FF = 5504, NBATCH = 2, SEQ = 4096, LP = 4160, MR = NBATCH * LP, MP = 8448, NCH = 65;
constexpr int NIN = 17664, NGU = 2 * FF;
constexpr int ZQ_G = 0, ZK_G = 512, ZV_G = 1024, ZG_G = 2048, ZQ_R = 3072, ZK_R = 4096, ZV_R = 5120, ZG_R = 6144, ZQ_H = 7168, ZF_H = 8192, ZI_H = 9216, ZG_H = 10240, ZMG = 11264, ZLR = 17408;
constexpr float EPS = 1e-6f;
constexpr int NPOS = 4112;

constexpr size_t al256(size_t x) { return (x + 255) & ~(size_t)255; }
constexpr size_t WS_SSQ = 0;
constexpr size_t WS_ROPE = al256(WS_SSQ + (size_t)7 * MP * 8);
constexpr size_t WS_LAMG = al256(WS_ROPE + (size_t)NPOS * 128 * 8);
constexpr size_t WS_LAMH = al256(WS_LAMG + (size_t)520 * 128 * 4);
constexpr size_t WS_W = al256(WS_LAMH + (size_t)1040 * 128 * 4);
constexpr size_t W_GU1 = 0, W_D1 = W_GU1 + (size_t)NGU * D * 2, W_IN = W_D1 + (size_t)D * FF * 2, W_B = W_IN + (size_t)NIN * D * 2, W_O = W_B + (size_t)3 * D * 1024 * 2,
                 W_GU2 = W_O + (size_t)D * D * 2, W_D2 = W_GU2 + (size_t)NGU * D * 2, W_END = W_D2 + (size_t)D * FF * 2;
constexpr size_t WS_H = al256(WS_W + W_END);
constexpr size_t WS_HB = al256(WS_H + (size_t)MP * D * 4);
constexpr size_t WS_Z = al256(WS_HB + (size_t)MP * D * 2);
constexpr size_t WS_QT = al256(WS_Z + (size_t)MP * NIN * 2);
constexpr size_t WS_KT = al256(WS_QT + (size_t)MR * 2560 * 2);
constexpr size_t WS_VT = al256(WS_KT + (size_t)MR * 2560 * 2);
constexpr size_t WS_P = al256(WS_VT + (size_t)MR * 3072 * 2);
constexpr size_t WS_O = al256(WS_P + (size_t)2080 * 4096 * 2);
constexpr size_t WS_MF = WS_O, WS_MB = WS_O + (size_t)MP * D * 4;
constexpr size_t WS_YS = al256(WS_O + (size_t)MP * 3072 * 4);
constexpr size_t WS_PART = al256(WS_YS + (size_t)MP * 3072 * 2);
constexpr size_t WS_CNT = al256(WS_PART + (size_t)21 * 8 * 128 * 256 * 4);
constexpr size_t WS_BAR = al256(WS_CNT + 4096);
constexpr size_t WS_O2 = al256(WS_BAR + 16384);
constexpr size_t WS_END = al256(WS_O2 + (size_t)MR * 1024 * 4);
static_assert(WS_MB + (size_t)MP * D * 2 <= WS_YS, "MF|MB alias O");
constexpr size_t QT_G = 0, QT_R = (size_t)520 * 64 * 128, QT_H = QT_R + (size_t)520 * 64 * 256;
constexpr size_t VT_G = 0, VT_R = (size_t)520 * 256 * 64, VT_H = VT_R + (size_t)520 * 256 * 64;
constexpr size_t P_G = 0, P_R = (size_t)520 * 4096, P_H = (size_t)1040 * 4096;

namespace pg8 {
constexpr int BM = 256, BK = 64, HALF = 128, HTB = HALF * BK * 2, STAGE_BYTES = 8 * HTB, NXCD = 8, WGM = 8;
__host__ __device__ __forceinline__ int lds_byte(int r, int c) { const int st = (r >> 4) * 2 + (c >> 5), rr = r & 15, cc = c & 31, ob = rr * 64 + cc * 2; return st * 1024 + (ob ^ (((ob >> 9) & 1) << 5)); }
__host__ __device__ __forceinline__ void stage_rc(int b, int& R, int& C) { const int st = b / 1024, sb = b % 1024, swz = sb ^ (((sb >> 9) & 1) << 5); R = (st >> 1) * 16 + swz / 64; C = (st & 1) * 32 + (swz % 64) / 2; }
__host__ __device__ __forceinline__ int perm32(int rho) { const int n = rho >> 4, i = rho & 15; return 8 * (i >> 2) + 4 * n + (i & 3); }

struct Unit { int pm, pn, tag, nt, rowoff, half; };
struct Gemm { const bf16* A; const bf16* Bt; int lda, ldb, K; size_t a_tag, b_tag; int b_div; size_t b_hi; };

struct StaticOrder {
    int nM, nN, nwg, G, c, reps, nt_all;
    __device__ void init(int M, int N, int G_, int c_, int reps_, int K) { nM = M / BM; nN = N / BM; nwg = nM * nN; G = G_; c = c_; reps = reps_; nt_all = K / BK; }
    __device__ void tile(int L, Unit& u) const {
        int wgid = L; { const int q = nwg / NXCD, r = nwg % NXCD, xcd = wgid % NXCD, off = wgid / NXCD; wgid = (xcd < r ? xcd * (q + 1) : r * (q + 1) + (xcd - r) * q) + off; }
        const int nig = WGM * nN, gid = wgid / nig, fm = gid * WGM, gsz = (nM - fm) < WGM ? (nM - fm) : WGM;
        u.pm = fm + ((wgid % nig) % gsz); u.pn = (wgid % nig) / gsz; u.nt = nt_all; u.rowoff = 0; u.half = 0;
    }
    __device__ bool next(int i, Unit& u) const {
        const int rep = i % reps; const long L = (long)(i / reps) * G + c; if (L >= nwg) return false;
        tile((int)L, u); u.tag = rep; return true;
    }
};
struct MainRounds {
    StaticOrder B; int nfull;
    __device__ void init(int Mmain, int N, int G_, int c_, int K) { B.init(Mmain, N, G_, c_, 1, K); nfull = (B.nwg / G_) * G_; }
    __device__ bool next(int i, Unit& u) const { const int L = i * B.G + B.c; if (L >= nfull) return false; B.tile(L, u); u.tag = 0; return true; }
};
struct TailHalves {
    StaticOrder B; int nfull, ntail, PM;
    __device__ void init(int Mmain, int N, int G_, int c_, int K) { B.init(Mmain, N, G_, c_, 1, K); nfull = (B.nwg / G_) * G_; ntail = B.nwg - nfull; PM = Mmain / BM; }
    __device__ bool next(int i, Unit& u) const {
        int j = i * B.G + B.c; u.tag = 0;
        if (j < 2 * ntail) { B.tile(nfull + (j >> 1), u); u.rowoff = (j & 1) * HALF; u.half = 1; return true; }
        j -= 2 * ntail;
        if (j < B.nN) { u.pm = PM; u.pn = j; u.nt = B.nt_all; u.rowoff = 0; u.half = 1; return true; }
        return false;
    }
};
struct SplitOrder {
    int nN, nP, nG, G, c, PM, nt_tot;
    __device__ void init(int PM_, int N, int K, int groups, int G_, int c_) { PM = PM_; nN = N / BM; nt_tot = K / BK; nP = nt_tot / 4; nG = groups; G = G_; c = c_; }
    __device__ bool next(int i, Unit& u) const {
        const int L = i * G + c; if (L >= nN * nP * nG) return false;
        u.pm = PM; u.pn = L % nN; u.tag = L / nN; const int p = u.tag % nP; u.nt = (p == nP - 1) ? nt_tot - 4 * (nP - 1) : 4; u.rowoff = 0; u.half = 0; return true;
    }
};


template <bool HALF_>
struct EpiGateUpT {
    static constexpr bool PERM = true, CHAIN = false, HALF_ONLY = HALF_;
    bf16* O; const u64* ssq;
    __device__ __forceinline__ void operator()(const f32x4 (&acc)[2][2][4][2], const Unit& u, int wr, int wc, int fr, int fq) const {
        const int row0 = u.pm * BM + u.rowoff + wr * 64 + fr, col0 = u.pn * 128 + wc * 32 + 8 * fq;
#pragma unroll
        for (int ai = 0; ai < (HALF_ ? 1 : 2); ++ai) {
#pragma unroll
            for (int m = 0; m < 4; ++m) {
                const int row = row0 + ai * HALF + m * 16; const float rs = __builtin_amdgcn_rsqf(ssq_get(ssq, row) * (1.f / D) + EPS);
                float a[8];
#pragma unroll
                for (int n = 0; n < 2; ++n)
#pragma unroll
                    for (int e = 0; e < 4; ++e) { const float g = acc[ai][0][m][n][e] * rs, uu = acc[ai][1][m][n][e] * rs; a[4 * n + e] = silu_f(g) * uu; }
                u32x4 w; w.x = cvtpk(a[0], a[1]); w.y = cvtpk(a[2], a[3]); w.z = cvtpk(a[4], a[5]); w.w = cvtpk(a[6], a[7]);
                *(u32x4*)(O + (size_t)row * FF + col0) = w; } }
    }
};
struct EpiRowScale {
    static constexpr bool PERM = true, CHAIN = false, HALF_ONLY = false;
    bf16* O; int ldc; const u64* ssq;
    __device__ __forceinline__ void operator()(const f32x4 (&acc)[2][2][4][2], const Unit& u, int wr, int wc, int fr, int fq) const {
        const int row0 = u.pm * BM + wr * 64 + fr, col0 = u.pn * BM + wc * 32 + 8 * fq;
#pragma unroll
        for (int ai = 0; ai < 2; ++ai)
#pragma unroll
            for (int m = 0; m < 4; ++m) {
                const int row = row0 + ai * HALF + m * 16; const float rs = __builtin_amdgcn_rsqf(ssq_get(ssq, row) * (1.f / D) + EPS);
                bf16* rowp = O + (size_t)row * ldc + col0;
#pragma unroll
                for (int bj = 0; bj < 2; ++bj) { const f32x4 v0 = acc[ai][bj][m][0] * rs, v1 = acc[ai][bj][m][1] * rs;
                    u32x4 w; w.x = cvtpk(v0[0], v0[1]); w.y = cvtpk(v0[2], v0[3]); w.z = cvtpk(v1[0], v1[1]); w.w = cvtpk(v1[2], v1[3]);
                    *(u32x4*)(rowp + bj * HALF) = w; } }
    }
};
struct EpiResid {
    static constexpr bool PERM = true, CHAIN = false, HALF_ONLY = false;
    float* H32; bf16* HB; u64* ssq_out; float scale;
    __device__ __forceinline__ void operator()(const f32x4 (&acc)[2][2][4][2], const Unit& u, int wr, int wc, int fr, int fq) const {
        const int row0 = u.pm * BM + wr * 64 + fr, col0 = u.pn * BM + wc * 32 + 8 * fq;
#pragma unroll
        for (int ai = 0; ai < 2; ++ai)
#pragma unroll
            for (int m = 0; m < 4; ++m) {
                const int row = row0 + ai * HALF + m * 16; const size_t off = (size_t)row * D + col0; float s = 0.f;
#pragma unroll
                for (int bj = 0; bj < 2; ++bj) { const size_t o = off + bj * HALF; const u32x4 hb = *(const u32x4*)(HB + o);
                    f32x4 h0 = (f32x4){bflo(hb.x), bfhi(hb.x), bflo(hb.y), bfhi(hb.y)}, h1 = (f32x4){bflo(hb.z), bfhi(hb.z), bflo(hb.w), bfhi(hb.w)};
                    h0 = h0 + acc[ai][bj][m][0] * scale; h1 = h1 + acc[ai][bj][m][1] * scale;
                    if (H32) { *(f32x4*)(H32 + o) = h0; *(f32x4*)(H32 + o + 4) = h1; }
                    u32x4 w; w.x = cvtpk(h0[0], h0[1]); w.y = cvtpk(h0[2], h0[3]); w.z = cvtpk(h1[0], h1[1]); w.w = cvtpk(h1[2], h1[3]); *(u32x4*)(HB + o) = w;
                    s += ((h0[0] * h0[0] + h0[1] * h0[1]) + (h0[2] * h0[2] + h0[3] * h0[3])) + ((h1[0] * h1[0] + h1[1] * h1[1]) + (h1[2] * h1[2] + h1[3] * h1[3])); }
                s += __shfl_xor(s, 16); s += __shfl_xor(s, 32);
                if (fq == 0) atomicAdd(ssq_out + row, ssq_fix(s)); }
    }
};
struct EpiBranch {
    static constexpr bool PERM = false, CHAIN = true, HALF_ONLY = false;
    const bf16* Z; bf16* MB;
    __device__ __forceinline__ void operator()(f32x4 (&acc)[2][2][4][2], const Unit& u, int wr, int wc, int fr, int fq) const {
        const int row0 = u.pm * BM + wr * 64 + fr, col0 = u.pn * BM + wc * 32 + 4 * fq; const int n_br = u.tag;
#pragma unroll
        for (int ai = 0; ai < 2; ++ai)
#pragma unroll
            for (int m = 0; m < 4; ++m) {
                const int row = row0 + ai * HALF + m * 16; const size_t off = (size_t)row * D + col0; const bf16* zr = Z + (size_t)row * NIN + ZMG + n_br * D + col0;
#pragma unroll
                for (int bj = 0; bj < 2; ++bj)
#pragma unroll
                    for (int n = 0; n < 2; ++n) { const int co = bj * HALF + n * 16; const u32x2 gz = *(const u32x2*)(zr + co);
                        const float z0[4] = {bflo(gz.x), bfhi(gz.x), bflo(gz.y), bfhi(gz.y)}; f32x4 v = acc[ai][bj][m][n];
                        if (n_br < 2) { const u32x2 gn = *(const u32x2*)(zr + D + co); const float z1[4] = {bflo(gn.x), bfhi(gn.x), bflo(gn.y), bfhi(gn.y)};
#pragma unroll
                            for (int e = 0; e < 4; ++e) v[e] *= (1.f + __expf(-fminf(fmaxf(z1[e], -30.f), 30.f))) * __builtin_amdgcn_rcpf(1.f + __expf(-fminf(fmaxf(z0[e], -30.f), 30.f)));
                            acc[ai][bj][m][n] = v;
                        } else {
#pragma unroll
                            for (int e = 0; e < 4; ++e) v[e] *= __builtin_amdgcn_rcpf(1.f + __expf(-fminf(fmaxf(z0[e], -30.f), 30.f)));
                            u32x2 w; w.x = cvtpk(v[0], v[1]); w.y = cvtpk(v[2], v[3]); *(u32x2*)(MB + off + co) = w; } } }
    }
};
__device__ __forceinline__ void wt_store4(float* p, f32x4 v) {
    __hip_atomic_store((u64*)p, ((u64)__float_as_uint(v[1]) << 32) | __float_as_uint(v[0]), __ATOMIC_RELAXED, __HIP_MEMORY_SCOPE_AGENT);
    __hip_atomic_store((u64*)p + 1, ((u64)__float_as_uint(v[3]) << 32) | __float_as_uint(v[2]), __ATOMIC_RELAXED, __HIP_MEMORY_SCOPE_AGENT);
}
__device__ __forceinline__ f32x4 wt_load4(const float* p) {
    const u64 a = __hip_atomic_load((const u64*)p, __ATOMIC_RELAXED, __HIP_MEMORY_SCOPE_AGENT), b = __hip_atomic_load((const u64*)p + 1, __ATOMIC_RELAXED, __HIP_MEMORY_SCOPE_AGENT);
    return (f32x4){__uint_as_float((unsigned)a), __uint_as_float((unsigned)(a >> 32)), __uint_as_float((unsigned)b), __uint_as_float((unsigned)(b >> 32))};
}
__device__ __forceinline__ void split_store(const f32x4 (&acc)[2][2][4][2], float* part, int wr, int wc, int fr, int fq) {
#pragma unroll
    for (int m = 0; m < 4; ++m)
#pragma unroll
        for (int bj = 0; bj < 2; ++bj)
#pragma unroll
            for (int n = 0; n < 2; ++n) wt_store4(part + (size_t)(wr * 64 + m * 16 + fr) * 256 + bj * HALF + wc * 32 + n * 16 + 4 * fq, acc[0][bj][m][n]);
}
struct EpiSplitStore {
    static constexpr bool PERM = false, CHAIN = false, HALF_ONLY = false;
    unsigned char* ws; int cnt_idx;
    __device__ __forceinline__ void operator()(const f32x4 (&acc)[2][2][4][2], const Unit& u, int wr, int wc, int fr, int fq) const {
        split_store(acc, (float*)(ws + WS_PART) + (size_t)(u.tag * 8 + u.pn) * 128 * 256, wr, wc, fr, fq);
        asm volatile("s_waitcnt vmcnt(0)" ::: "memory");
        __syncthreads();
        if ((wr | wc | fr | fq) == 0) __hip_atomic_fetch_add((unsigned*)(ws + WS_CNT) + cnt_idx + u.pn, 1u, __ATOMIC_RELAXED, __HIP_MEMORY_SCOPE_AGENT);
    }
};
__device__ __forceinline__ void split_wait(unsigned* cnt, unsigned total, int tid) {
    if (tid == 0) { unsigned spins = 0; while (__hip_atomic_load(cnt, __ATOMIC_RELAXED, __HIP_MEMORY_SCOPE_AGENT) < total && ++spins < (1u << 22)) __builtin_amdgcn_s_sleep(1); }
    __syncthreads();
}
__device__ __forceinline__ void split_finish_resid(unsigned char* ws, int ssq_idx, float scale, int cnt_idx, int nP, int pm, int unit, int tid, bool keep32) {
    if (unit >= 8 * nP) return;
    const int pn = unit % 8, tag = unit / 8;
    float* const H32 = (float*)(ws + WS_H); bf16* const HB = (bf16*)(ws + WS_HB); u64* const ssq_out = (u64*)(ws + WS_SSQ) + (size_t)ssq_idx * MP; const float* const PART = (const float*)(ws + WS_PART);
    split_wait((unsigned*)(ws + WS_CNT) + cnt_idx + pn, (unsigned)nP, tid);
    const int wave = tid >> 6, lane = tid & 63;
    for (int rl = tag + nP * wave; rl < 128; rl += nP * 8) {
        f32x4 a = (f32x4){0.f, 0.f, 0.f, 0.f};
        const float* pp = PART + ((size_t)pn * 128 + rl) * 256 + 4 * lane;
#pragma unroll 8
        for (int p = 0; p < nP; ++p) a = a + wt_load4(pp + (size_t)p * 8 * 128 * 256);
        const int row = pm * BM + rl; const size_t off = (size_t)row * D + pn * BM + 4 * lane;
        const u32x2 hb = *(const u32x2*)(HB + off); f32x4 hv = (f32x4){bflo(hb.x), bfhi(hb.x), bflo(hb.y), bfhi(hb.y)}; hv = hv + a * scale; if (keep32) *(f32x4*)(H32 + off) = hv;
        u32x2 w; w.x = cvtpk(hv[0], hv[1]); w.y = cvtpk(hv[2], hv[3]); *(u32x2*)(HB + off) = w;
        float sq = (hv[0] * hv[0] + hv[1] * hv[1]) + (hv[2] * hv[2] + hv[3] * hv[3]);
#pragma unroll
        for (int o = 1; o < 64; o <<= 1) sq += __shfl_xor(sq, o);
        if (lane == 0) atomicAdd(ssq_out + row, ssq_fix(sq));
    }
}
__device__ __forceinline__ void split_finish_branch(unsigned char* ws, int cnt_idx, int nP, int pm, int unit, int tid) {
    const int nU = 3 * nP;
    if (unit >= 8 * nU) return;
    const int pn = unit % 8, tag = unit / 8;
    const bf16* const Z = (const bf16*)(ws + WS_Z); bf16* const MB = (bf16*)(ws + WS_MB); const float* const PART = (const float*)(ws + WS_PART);
    split_wait((unsigned*)(ws + WS_CNT) + cnt_idx + pn, (unsigned)nU, tid);
    const int wave = tid >> 6, lane = tid & 63;
    for (int rl = tag + nU * wave; rl < 128; rl += nU * 8) {
        const int row = pm * BM + rl; const size_t off = (size_t)row * D + pn * BM + 4 * lane;
        const float* pp = PART + ((size_t)pn * 128 + rl) * 256 + 4 * lane;
        f32x4 v = (f32x4){0.f, 0.f, 0.f, 0.f};
#pragma unroll
        for (int nb = 0; nb < 3; ++nb) { f32x4 a = (f32x4){0.f, 0.f, 0.f, 0.f};
            for (int p = 0; p < nP; ++p) a = a + wt_load4(pp + (size_t)(nb * nP + p) * 8 * 128 * 256);
            const u32x2 gz = *(const u32x2*)(Z + (size_t)row * NIN + ZMG + nb * D + pn * BM + 4 * lane);
            v[0] += a[0] * sigmoid_f(bflo(gz.x)); v[1] += a[1] * sigmoid_f(bfhi(gz.x)); v[2] += a[2] * sigmoid_f(bflo(gz.y)); v[3] += a[3] * sigmoid_f(bfhi(gz.y)); }
        u32x2 w; w.x = cvtpk(v[0], v[1]); w.y = cvtpk(v[2], v[3]); *(u32x2*)(MB + off) = w;
    }
}

template <class Epi, class Sched>
__device__ __forceinline__ void gemm_phase(LAS unsigned char* lds, const Gemm g, const Sched& S, const Epi& E, const int tid) {
    const int wid = __builtin_amdgcn_readfirstlane(tid >> 6), lane = tid & 63, wr = wid >> 2, wc = wid & 3, fr = lane & 15, fq = lane >> 4;
    unsigned voffA[2], voffB[2];
#pragma unroll
    for (int i = 0; i < 2; ++i) { int R, C; stage_rc(tid * 16 + i * 8192, R, C); const int Rb = Epi::PERM ? ((R & ~31) + perm32(R & 31)) : R;
        voffA[i] = (unsigned)(R * g.lda + C) * 2u; voffB[i] = (unsigned)(Rb * g.ldb + C) * 2u; }
    const size_t kstep = (size_t)(BK * 2);
    const size_t hstepA = (size_t)HALF * g.lda * 2, hstepB = (size_t)HALF * g.ldb * 2;
    const size_t tstepA = 2 * hstepA, tstepB = 2 * hstepB;
    const unsigned ldsw = (unsigned)wid * 1024u;
    const int aoff = lds_byte(wr * 64 + fr, fq * 8), boff = lds_byte(wc * 32 + fr, fq * 8);
#define PG8_SA(b, h) (((b) * 2 + (h)) * HTB)
#define PG8_SB(b, h) ((4 + (b) * 2 + (h)) * HTB)
#define PG8_STAGE(bufoff, gbase, voff) do { _Pragma("unroll") for (int _i = 0; _i < 2; ++_i) \
        __builtin_amdgcn_global_load_lds((const unsigned*)((const char*)(gbase) + (voff)[_i]), (LAS unsigned*)(lds + (bufoff) + ldsw + _i * 8192), 16, 0, 0); } while (0)
#define PG8_LDA(dst, b, h) do { _Pragma("unroll") for (int m = 0; m < 4; ++m) _Pragma("unroll") for (int k = 0; k < 2; ++k) dst[m][k] = *(const LAS bf16x8*)(lds + PG8_SA(b, h) + aoff + m * 2048 + k * 1024); } while (0)
#define PG8_LDB(dst, b, h) do { _Pragma("unroll") for (int n = 0; n < 2; ++n) _Pragma("unroll") for (int k = 0; k < 2; ++k) dst[n][k] = *(const LAS bf16x8*)(lds + PG8_SB(b, h) + boff + n * 2048 + k * 1024); } while (0)
#define PG8_MMA(ai, bj, At, Bt) do { __builtin_amdgcn_s_setprio(1); _Pragma("unroll") for (int m = 0; m < 4; ++m) _Pragma("unroll") for (int n = 0; n < 2; ++n) _Pragma("unroll") for (int k = 0; k < 2; ++k) \
        acc[ai][bj][m][n] = __builtin_amdgcn_mfma_f32_16x16x32_bf16(Bt[n][k], At[m][k], acc[ai][bj][m][n], 0, 0, 0); __builtin_amdgcn_s_setprio(0); } while (0)
#define PG8_WAIT_V(n) asm volatile("s_waitcnt vmcnt(" #n ")" ::: "memory")
#define PG8_WAIT_L(n) asm volatile("s_waitcnt lgkmcnt(" #n ")" ::: "memory")
#define PG8_BAR __builtin_amdgcn_s_barrier()
#define PG8_SCHED __builtin_amdgcn_sched_barrier(0)
    Unit cur, nxt; int ui = 0;
    if (!S.next(0, cur)) return;
    float z0 = 0.f; asm volatile("" : "+v"(z0));
    f32x4 acc[2][2][4][2];
#pragma unroll
    for (int a = 0; a < 2; ++a)
#pragma unroll
        for (int b = 0; b < 2; ++b)
#pragma unroll
            for (int m = 0; m < 4; ++m)
#pragma unroll
                for (int n = 0; n < 2; ++n) acc[a][b][m][n] = (f32x4){z0, z0, z0, z0};
    bf16x8 At[4][2], B0[2][2], B1[2][2];
    const char* cA = (const char*)g.A + (size_t)cur.pm * tstepA + (size_t)cur.rowoff * g.lda * 2 + (size_t)cur.tag * g.a_tag; const char* cB = (const char*)g.Bt + (size_t)cur.pn * tstepB + (size_t)(cur.tag % g.b_div) * g.b_tag + (size_t)(cur.tag / g.b_div) * g.b_hi;
    PG8_STAGE(PG8_SB(0, 0), cB, voffB); PG8_STAGE(PG8_SB(0, 1), cB + hstepB, voffB); PG8_STAGE(PG8_SA(0, 0), cA, voffA); PG8_STAGE(PG8_SA(0, 1), cA + hstepA, voffA);
    if (wr == 1) PG8_BAR;
    PG8_WAIT_V(2); PG8_BAR;
    PG8_STAGE(PG8_SB(1, 0), cB + kstep, voffB); PG8_STAGE(PG8_SA(1, 0), cA + kstep, voffA); PG8_STAGE(PG8_SB(1, 1), cB + hstepB + kstep, voffB);
    PG8_WAIT_V(6); PG8_BAR;
    for (;;) {
        const bool has_next = S.next(ui + 1, nxt);
        const char* nA = has_next ? (const char*)g.A + (size_t)nxt.pm * tstepA + (size_t)nxt.rowoff * g.lda * 2 + (size_t)nxt.tag * g.a_tag : cA;
        const char* nB = has_next ? (const char*)g.Bt + (size_t)nxt.pn * tstepB + (size_t)(nxt.tag % g.b_div) * g.b_tag + (size_t)(nxt.tag / g.b_div) * g.b_hi : cB;
        const int nt = cur.nt;
        for (int t = 0; t < nt; t += 2) {
            const bool last = (t == nt - 2);
            const char* a1 = cA + (size_t)(t + 1) * kstep;
            const char* a2 = last ? nA : cA + (size_t)(t + 2) * kstep; const char* b2 = last ? nB : cB + (size_t)(t + 2) * kstep;
            const char* a3 = a2 + kstep; const char* b3 = b2 + kstep;
            PG8_LDB(B0, 0, 0); PG8_LDB(B1, 0, 1); PG8_SCHED; PG8_LDA(At, 0, 0); PG8_STAGE(PG8_SA(1, 1), a1 + hstepA, voffA);
            PG8_WAIT_V(8); PG8_WAIT_L(0); PG8_BAR; PG8_MMA(0, 0, At, B0); PG8_MMA(0, 1, At, B1); PG8_BAR; PG8_SCHED;
            PG8_LDA(At, 0, 1); PG8_STAGE(PG8_SB(0, 0), b2, voffB); PG8_STAGE(PG8_SB(0, 1), b2 + hstepB, voffB); PG8_STAGE(PG8_SA(0, 0), a2, voffA);
            PG8_WAIT_V(8); PG8_WAIT_L(0); PG8_BAR; if constexpr (!Epi::HALF_ONLY) { PG8_MMA(1, 0, At, B0); PG8_MMA(1, 1, At, B1); } PG8_BAR; PG8_SCHED;
            PG8_LDB(B0, 1, 0); PG8_LDB(B1, 1, 1); PG8_SCHED; PG8_LDA(At, 1, 0); PG8_STAGE(PG8_SA(0, 1), a2 + hstepA, voffA);
            PG8_WAIT_V(8); PG8_WAIT_L(0); PG8_BAR; PG8_MMA(0, 0, At, B0); PG8_MMA(0, 1, At, B1); PG8_BAR; PG8_SCHED;
            PG8_LDA(At, 1, 1); PG8_STAGE(PG8_SB(1, 0), b3, voffB); PG8_STAGE(PG8_SB(1, 1), b3 + hstepB, voffB); PG8_STAGE(PG8_SA(1, 0), a3, voffA);
            PG8_WAIT_V(8); PG8_WAIT_L(0); PG8_BAR; if constexpr (!Epi::HALF_ONLY) { PG8_MMA(1, 0, At, B0); PG8_MMA(1, 1, At, B1); } PG8_BAR; PG8_SCHED;
        }
        if (wr == 0) PG8_BAR;
        E(acc, cur, wr, wc, fr, fq);
        if (!has_next) break;
        if (!Epi::CHAIN || cur.tag == 2) {
#pragma unroll
        for (int a = 0; a < 2; ++a)
#pragma unroll
            for (int b = 0; b < 2; ++b)
#pragma unroll
                for (int m = 0; m < 4; ++m)
#pragma unroll
                    for (int n = 0; n < 2; ++n) acc[a][b][m][n] = (f32x4){z0, z0, z0, z0};
        }
        cur = nxt; cA = nA; cB = nB; ++ui;
        if (wr == 1) PG8_BAR;
    }
    PG8_WAIT_V(0);
    PG8_BAR;
#undef PG8_SA
#undef PG8_SB
#undef PG8_STAGE
#undef PG8_LDA
#undef PG8_LDB
#undef PG8_MMA
#undef PG8_WAIT_V
#undef PG8_WAIT_L
#undef PG8_BAR
#undef PG8_SCHED
}
}

constexpr int LDS_BYTES = 147456;
constexpr int NPHASE = 22;

struct Args { const float* in[21]; float* out; unsigned char* ws; int ph_lo, ph_hi; };

struct Frame {
    LAS unsigned char* lds;
    int tid, lane, wave, vcu, G, bid;
    const float* const* in;
    unsigned char* ws;
};

__device__ __forceinline__ float wave_sum(float v) {
#pragma unroll
    for (int o = 1; o < 64; o <<= 1) v += __shfl_xor(v, o);
    return v;
}

__device__ __forceinline__ void conv_item(const float* W, int ldw, int col0, int nvalid, const float* gain, float scale, bf16* dst, int K, int k0, LAS float* scr, int lane) {
    const int n4 = (lane & 15) * 4, kq = lane >> 4;
    const float* wp = W + (size_t)(k0 + kq) * ldw + col0 + n4; const size_t wstep = (size_t)4 * ldw;
    f32x4 v[16];
#pragma unroll
    for (int i = 0; i < 16; ++i) { v[i] = (f32x4){0.f, 0.f, 0.f, 0.f}; if (n4 < nvalid) v[i] = *(const GAS f32x4*)(wp + (size_t)i * wstep); }
#pragma unroll
    for (int i = 0; i < 16; ++i) { const int kk = 4 * i + kq; const float g = (gain ? gain[k0 + kk] : 1.f) * scale; LAS float* sp = scr + kk * 65 + n4;
        sp[0] = v[i][0] * g; sp[1] = v[i][1] * g; sp[2] = v[i][2] * g; sp[3] = v[i][3] * g; }
    asm volatile("s_waitcnt lgkmcnt(0)" ::: "memory");
    const int c = lane & 7;
#pragma unroll
    for (int j = 0; j < 8; ++j) { const int n = (lane >> 3) + 8 * j; const LAS float* s = scr + (8 * c) * 65 + n;
        u32x4 o; o.x = cvtpk(s[0 * 65], s[1 * 65]); o.y = cvtpk(s[2 * 65], s[3 * 65]); o.z = cvtpk(s[4 * 65], s[5 * 65]); o.w = cvtpk(s[6 * 65], s[7 * 65]);
        *(GAS u32x4*)(dst + (size_t)n * K + 8 * c) = o; }
    asm volatile("s_waitcnt lgkmcnt(0)" ::: "memory");
}

constexpr int CI_GU = (NGU / 64) * (D / 64), CI_D = (D / 64) * (FF / 64), CI_IN = (NIN / 64) * (D / 64), CI_B = 3 * (D / 64) * (1024 / 64), CI_O = (D / 64) * (D / 64);
constexpr int CI_PARTA = CI_GU + CI_D + CI_IN, CI_ALL = CI_PARTA + CI_B + CI_O + CI_GU + CI_D;
__device__ __forceinline__ void convert_range(Frame& F, int L, int lo, int hi, int gw, int NGW) {
    LAS float* scr = (LAS float*)(F.lds + F.wave * 16640);
    unsigned char* wb = F.ws + WS_W;
    for (int it = lo + gw; it < hi; it += NGW) {
        int r = it, f = 0;
        if (r >= CI_PARTA + CI_B + CI_O) { f = 1; r -= CI_PARTA + CI_B + CI_O; }
        const float* W; const float* gain = nullptr; bf16* dst; int ldw, col0, nvalid = 64, K, kb; float sc = 1.f;
        if (r < CI_GU) {
            const int nb = r % (NGU / 64); kb = r / (NGU / 64);
            const int j = nb >> 2, half = (nb >> 1) & 1, sub = nb & 1;
            W = (half ? F.in[f ? 18 : 4] : F.in[f ? 17 : 3]) + (size_t)L * D * FF; gain = F.in[f ? 16 : 2] + (size_t)L * D; ldw = FF; col0 = j * 128 + sub * 64; K = D;
            dst = (bf16*)(wb + (f ? W_GU2 : W_GU1)) + (size_t)(nb * 64) * D;
        } else if (r < CI_GU + CI_D) { r -= CI_GU;
            const int nb = r % (D / 64); kb = r / (D / 64);
            W = F.in[f ? 19 : 5] + (size_t)L * FF * D; ldw = D; col0 = nb * 64; K = FF;
            dst = (bf16*)(wb + (f ? W_D2 : W_D1)) + (size_t)(nb * 64) * FF;
        } else if (r < CI_PARTA) { r -= CI_GU + CI_D;
            const int nb = r % (NIN / 64); kb = r / (NIN / 64); const int n0 = nb * 64;
            if (n0 < 3072) col0 = n0; else if (n0 < ZLR) col0 = n0 + 16; else if (n0 == ZLR) { col0 = 3072; nvalid = 16; } else { col0 = 0; nvalid = 0; }
            if (n0 < 512) sc = 0.08838834764831845f;
            else if (n0 >= ZQ_R && n0 < ZK_R) sc = 0.0625f;
            W = F.in[7] + (size_t)L * D * 17424; gain = F.in[6] + (size_t)L * D; ldw = 17424; K = D;
            dst = (bf16*)(wb + W_IN) + (size_t)n0 * D;
        } else if (r < CI_PARTA + CI_B) { r -= CI_PARTA;
            const int n = r / (CI_B / 3); r -= n * (CI_B / 3); const int nb = r % (D / 64); kb = r / (D / 64);
            W = F.in[14] + ((size_t)L * 3 + n) * 1024 * D; ldw = D; col0 = nb * 64; K = 1024;
            dst = (bf16*)(wb + W_B) + ((size_t)n * D + nb * 64) * 1024;
        } else { r -= CI_PARTA + CI_B;
            const int nb = r % (D / 64); kb = r / (D / 64);
            W = F.in[15] + (size_t)L * D * D; ldw = D; col0 = nb * 64; K = D;
            dst = (bf16*)(wb + W_O) + (size_t)(nb * 64) * D; }
        conv_item(W, ldw, col0, nvalid, gain, sc, dst + kb * 64, K, kb * 64, scr, F.lane);
    }
}

__device__ __forceinline__ void init_phase(Frame& F) {
    const int gw = F.vcu * 8 + F.wave, NGW = F.G * 8;
    float* H = (float*)(F.ws + WS_H); bf16* HB = (bf16*)(F.ws + WS_HB); u64* ssq = (u64*)(F.ws + WS_SSQ);
    for (int r = gw; r < MP; r += NGW) {
        const float* src = nullptr;
        if (r < MR) { const int b = r / LP, p = r % LP; if (p >= 64) src = F.in[0] + ((size_t)b * SEQ + (p - 64)) * D; else if (p >= 48) src = F.in[1] + (size_t)(p - 48) * D; }
        f32x4 v[8]; float s = 0.f;
#pragma unroll
        for (int j = 0; j < 8; ++j) { v[j] = src ? ((const GAS f32x4*)src)[F.lane + 64 * j] : (f32x4){0.f, 0.f, 0.f, 0.f}; s += (v[j][0] * v[j][0] + v[j][1] * v[j][1]) + (v[j][2] * v[j][2] + v[j][3] * v[j][3]); }
        s = wave_sum(s);
#pragma unroll
        for (int j = 0; j < 8; ++j) { u32x2 w; w.x = cvtpk(v[j][0], v[j][1]); w.y = cvtpk(v[j][2], v[j][3]); ((GAS u32x2*)(HB + (size_t)r * D))[F.lane + 64 * j] = w; }
        if (F.lane == 0) ((GAS u64*)ssq)[r] = ssq_fix(s);
    }
    const int gt = F.vcu * 512 + F.tid, NT = F.G * 512;
    for (int i = gt; i < 6 * MP; i += NT) ssq[MP + i] = 0ull;
    if (gt < 1024) ((unsigned*)(F.ws + WS_CNT))[gt] = 0u;
    float* rope = (float*)(F.ws + WS_ROPE);
    for (int i = gt; i < NPOS * 128; i += NT) { const int pos = i >> 7, k = i & 127;
        const float inv = exp2f(-(float)k * (13.287712379549449f / 128.f)); const float ang = (float)pos * inv;
        const double rev = (double)ang * 0.15915494309189535; const float fr = (float)(rev - __builtin_rint(rev));
        rope[2 * i] = __builtin_amdgcn_cosf(fr); rope[2 * i + 1] = __builtin_amdgcn_sinf(fr); }
}

template <int DV>
__device__ __forceinline__ void write_vT(int tid, const bf16* Zv  , bf16* VTci, bool do_silu) {
#pragma unroll
    for (int n = 0; n < DV / 128; ++n) { const int idx = tid + 512 * n, e = idx % DV, jb = idx / DV; unsigned w[8];
#pragma unroll
        for (int jj = 0; jj < 8; ++jj) { unsigned short v0 = Zv[(size_t)(16 * jb + 2 * jj) * NIN + e], v1 = Zv[(size_t)(16 * jb + 2 * jj + 1) * NIN + e];
            if (do_silu) w[jj] = cvtpk(silu_f(bf2f(v0)), silu_f(bf2f(v1))); else w[jj] = (unsigned)v0 | ((unsigned)v1 << 16); }
        GAS u32x4* dst = (GAS u32x4*)(VTci + (size_t)e * 64 + 16 * jb); dst[0] = (u32x4){w[0], w[1], w[2], w[3]}; dst[1] = (u32x4){w[4], w[5], w[6], w[7]}; }
}

template <int NC>
__device__ __forceinline__ void stage_tile(LAS unsigned char* dst, const bf16* src, int tid) {
#pragma unroll
    for (int n = 0; n < (64 * NC / 8) / 512; ++n) { const int idx = tid + 512 * n, row = idx / (NC / 8), cp = idx % (NC / 8);
        *(LAS u32x4*)(dst + row * (NC * 2) + cp * 16) = *(const GAS u32x4*)(src + (size_t)row * NIN + cp * 8); }
}
template <int DV>
__device__ __forceinline__ void write_vT_lds(int tid, const LAS unsigned short* vs, bf16* VTci, bool do_silu) {
#pragma unroll
    for (int n = 0; n < DV / 128; ++n) { const int idx = tid + 512 * n, e = idx % DV, jb = idx / DV; unsigned w[8];
#pragma unroll
        for (int jj = 0; jj < 8; ++jj) { const unsigned short v0 = vs[(16 * jb + 2 * jj) * DV + e], v1 = vs[(16 * jb + 2 * jj + 1) * DV + e];
            if (do_silu) w[jj] = cvtpk(silu_f(bf2f(v0)), silu_f(bf2f(v1))); else w[jj] = (unsigned)v0 | ((unsigned)v1 << 16); }
        GAS u32x4* dst = (GAS u32x4*)(VTci + (size_t)e * 64 + 16 * jb); dst[0] = (u32x4){w[0], w[1], w[2], w[3]}; dst[1] = (u32x4){w[4], w[5], w[6], w[7]}; }
}

constexpr int PR_W2S = 0, PR_BS = 8192, PR_GLR = 8704, PR_TOT = 12800, PR_QH = 14848, PR_HB = 32 * 272, PR_KH = PR_QH + 3 * PR_HB, PR_END = PR_KH + 3 * PR_HB, PR_RAWQ = PR_END, PR_RAWK = PR_RAWQ + 16384, PR_RAWV = PR_RAWK + 16384;
template <int BR>
__device__ __forceinline__ void prep_gh(Frame& F, int L, int item) {
    constexpr int H = BR == 0 ? 4 : 8, DV = BR == 0 ? 256 : 128;
    const int h = item % H, bc = item / H, c = bc % NCH, b = bc / NCH, rowb = b * LP + c * 64, ci = item;
    LAS float* w2s = (LAS float*)(F.lds + PR_W2S); LAS float* bs = (LAS float*)(F.lds + PR_BS); LAS float* glr = (LAS float*)(F.lds + PR_GLR); LAS float* tot = (LAS float*)(F.lds + PR_TOT);
    int t_ = F.tid; asm volatile("" : "+v"(t_));
    const int t = t_, d = t & 127, i0 = t >> 7;
    const bf16* Z = (const bf16*)(F.ws + WS_Z) + (size_t)rowb * NIN;
    float lbv = 0.f;
    stage_tile<128>(F.lds + PR_RAWQ, Z + (BR == 0 ? ZQ_G : ZQ_H) + h * 128, t);
    stage_tile<128>(F.lds + PR_RAWK, Z + (BR == 0 ? ZK_G : ZF_H) + h * 128, t);
    stage_tile<DV>(F.lds + PR_RAWV, Z + (BR == 0 ? ZV_G : ZI_H) + h * DV, t);
    if (BR == 0) {
        const float* w2 = F.in[8] + (size_t)L * 16 * 512; const float* bg = F.in[9] + (size_t)L * 512;
        for (int idx = t; idx < 2048; idx += 512) w2s[idx] = ((const GAS float*)w2)[(idx >> 7) * 512 + h * 128 + (idx & 127)];
        if (t < 128) bs[t] = ((const GAS float*)bg)[h * 128 + t];
        for (int idx = t; idx < 1024; idx += 512) glr[idx] = bf2f(((const GAS bf16*)Z)[(size_t)(idx >> 4) * NIN + ZLR + (idx & 15)]);
    } else if (L == 1) {
        const float l0 = F.in[12][h * 128 + d], l1 = F.in[12][1024 + h * 128 + d]; const float mx = fmaxf(l0, l1), e0 = __expf(l0 - mx), e1 = __expf(l1 - mx); lbv = e1 / (e0 + e1);
    }
    __syncthreads();
    float qv[16], kv[16], cv[16]; float run = 0.f;
    unsigned short rawq[16], rawk[16];
#pragma unroll
    for (int ii = 0; ii < 16; ++ii) { rawq[ii] = ((const LAS unsigned short*)(F.lds + PR_RAWQ))[(16 * i0 + ii) * 128 + d]; rawk[ii] = ((const LAS unsigned short*)(F.lds + PR_RAWK))[(16 * i0 + ii) * 128 + d]; }
#pragma unroll
    for (int ii = 0; ii < 16; ++ii) { const int i = 16 * i0 + ii; float q = bf2f(rawq[ii]), k, gl;
        if (BR == 0) { k = bf2f(rawk[ii]); float x = bs[d];
#pragma unroll
            for (int j = 0; j < 16; ++j) x += glr[i * 16 + j] * w2s[j * 128 + d];
            gl = (fminf(x, 0.f) - __logf(1.f + __expf(-fabsf(x)))) * (1.f / 16.f);
        } else { const float hf = bf2f(rawk[ii]); const float e = __expf(fminf(-hf, 80.f)), sg = __builtin_amdgcn_rcpf(1.f + e);
            gl = __logf(fmaxf(lbv + (1.f - lbv) * sg, 1e-20f)); k = (1.f - lbv) * e * sg; }
        run += gl; qv[ii] = q; kv[ii] = k; cv[ii] = run;
        if ((ii & 3) == 3) __builtin_amdgcn_sched_barrier(0); }
    tot[i0 * 128 + d] = run;
    __syncthreads();
    const float t0 = tot[d], t1 = tot[128 + d], t2 = tot[256 + d], t3 = tot[384 + d];
    const float r15 = t0, r31 = t0 + t1, r47 = r31 + t2, last = r47 + t3;
    const float off = i0 == 0 ? 0.f : (i0 == 1 ? r15 : (i0 == 2 ? r31 : r47));
#pragma unroll
    for (int ii = 0; ii < 16; ++ii) cv[ii] += off;
    bf16* QT = (bf16*)(F.ws + WS_QT) + (BR == 0 ? QT_G : QT_H) + (size_t)ci * 64 * 128;
    bf16* KT = (bf16*)(F.ws + WS_KT) + (BR == 0 ? QT_G : QT_H) + (size_t)ci * 128 * 64;
    bf16* Pm = (bf16*)(F.ws + WS_P) + (BR == 0 ? P_G : P_H) + (size_t)ci * 4096;
    float* LAM = (float*)(F.ws + (BR == 0 ? WS_LAMG : WS_LAMH)) + (size_t)ci * 128;
#pragma unroll
    for (int ii = 0; ii < 16; ++ii) ((GAS bf16*)QT)[(16 * i0 + ii) * 128 + d] = f2bf(qv[ii] * __expf(cv[ii]));
    if (i0 == 0) ((GAS float*)LAM)[d] = __expf(last);
    { unsigned w[8];
#pragma unroll
      for (int jj = 0; jj < 8; ++jj) w[jj] = cvtpk(kv[2 * jj] * __expf(last - cv[2 * jj]), kv[2 * jj + 1] * __expf(last - cv[2 * jj + 1]));
      GAS u32x4* dst = (GAS u32x4*)(KT + (size_t)d * 64 + 16 * i0); dst[0] = (u32x4){w[0], w[1], w[2], w[3]}; dst[1] = (u32x4){w[4], w[5], w[6], w[7]}; }
    {
        LAS unsigned short* QH = (LAS unsigned short*)(F.lds + PR_QH); LAS unsigned short* KH = (LAS unsigned short*)(F.lds + PR_KH);
        const int il = (16 * i0) & 31;
        if (i0 < 2) {
#pragma unroll
            for (int ii = 0; ii < 16; ++ii) { const int o = (il + ii) * 136 + d;
                QH[o] = f2bf(qv[ii] * __expf(fminf(cv[ii] - r15, 80.f))); KH[o] = f2bf(kv[ii] * __expf(fminf(r15 - cv[ii], 80.f))); KH[(PR_HB / 2) + o] = f2bf(kv[ii] * __expf(r31 - cv[ii])); }
        } else {
#pragma unroll
            for (int ii = 0; ii < 16; ++ii) { const int o = (il + ii) * 136 + d;
                QH[(PR_HB / 2) + o] = f2bf(qv[ii] * __expf(cv[ii] - r31)); QH[2 * (PR_HB / 2) + o] = f2bf(qv[ii] * __expf(fminf(cv[ii] - r47, 80.f))); KH[2 * (PR_HB / 2) + o] = f2bf(kv[ii] * __expf(fminf(r47 - cv[ii], 80.f))); }
        }
    }
    __syncthreads();
    { const int w = F.wave, r = F.lane & 15, q = F.lane >> 4;
#pragma unroll
      for (int tt = 0; tt < 2; ++tt) { const int T = w + 8 * tt, ti = T >> 2, tj = T & 3, I = ti >> 1, J = tj >> 1; f32x4 acc = (f32x4){0.f, 0.f, 0.f, 0.f};
          if (J <= I) { const int blk = I == 0 ? 0 : (J == 0 ? 1 : 2);
              const LAS unsigned char* qa = F.lds + PR_QH + blk * PR_HB + (16 * (ti & 1) + r) * 272 + 16 * q; const LAS unsigned char* kb = F.lds + PR_KH + blk * PR_HB + (16 * (tj & 1) + r) * 272 + 16 * q;
#pragma unroll
              for (int k = 0; k < 4; ++k) acc = __builtin_amdgcn_mfma_f32_16x16x32_bf16(*(const LAS bf16x8*)(kb + 64 * k), *(const LAS bf16x8*)(qa + 64 * k), acc, 0, 0, 0); }
          const int i = 16 * ti + r, j0 = 16 * tj + 4 * q;
          u32x2 pw; pw.x = cvtpk(j0 <= i ? acc[0] : 0.f, j0 + 1 <= i ? acc[1] : 0.f); pw.y = cvtpk(j0 + 2 <= i ? acc[2] : 0.f, j0 + 3 <= i ? acc[3] : 0.f);
          *(GAS u32x2*)(Pm + i * 64 + j0) = pw; } }
    write_vT_lds<DV>(t, (const LAS unsigned short*)(F.lds + PR_RAWV), (bf16*)(F.ws + WS_VT) + (BR == 0 ? VT_G : VT_H) + (size_t)ci * DV * 64, BR == 2);
    __syncthreads();
}

constexpr int RR_Q = 0, RR_K = 64 * 528, RR_RAWQ = 2 * 64 * 528, RR_RAWK = RR_RAWQ + 32768;
__device__ __forceinline__ void prep_ret(Frame& F, int item) {
    const int h = item % 4, bc = item / 4, c = bc % NCH, b = bc / NCH, rowb = b * LP + c * 64, ci = item;
    LAS unsigned short* QR = (LAS unsigned short*)(F.lds + RR_Q); LAS unsigned short* KR = (LAS unsigned short*)(F.lds + RR_K);
    int t_ = F.tid; asm volatile("" : "+v"(t_));
    const int t = t_, d = t & 127, i0 = t >> 7;
    const bf16* Z = (const bf16*)(F.ws + WS_Z) + (size_t)rowb * NIN;
    const float* rope = (const float*)(F.ws + WS_ROPE);
    const float lg = logf(1.f - exp2f(-5.f - (float)h));
    bf16* QT = (bf16*)(F.ws + WS_QT) + QT_R + (size_t)ci * 64 * 256;
    bf16* KT = (bf16*)(F.ws + WS_KT) + QT_R + (size_t)ci * 256 * 64;
    bf16* Pm = (bf16*)(F.ws + WS_P) + P_R + (size_t)ci * 4096;
    stage_tile<256>(F.lds + RR_RAWQ, Z + ZQ_R + h * 256, t);
    stage_tile<256>(F.lds + RR_RAWK, Z + ZK_R + h * 256, t);
    __syncthreads();
    float k0v[16], k1v[16];
#pragma unroll
    for (int hf = 0; hf < 4; ++hf) {
        unsigned short r1[4], r2[4], r3[4], r4[4]; f32x2 rc[4];
#pragma unroll
        for (int i8 = 0; i8 < 4; ++i8) { const int i = 16 * i0 + 4 * hf + i8; int pos = c * 64 + i - 48; pos = pos < 0 ? 0 : pos;
            const LAS unsigned short* rq_ = (const LAS unsigned short*)(F.lds + RR_RAWQ) + i * 256 + d; const LAS unsigned short* rk_ = (const LAS unsigned short*)(F.lds + RR_RAWK) + i * 256 + d;
            rc[i8] = *(const GAS f32x2*)(rope + ((size_t)pos * 128 + d) * 2); r1[i8] = rq_[0]; r2[i8] = rq_[128]; r3[i8] = rk_[0]; r4[i8] = rk_[128]; }
        __builtin_amdgcn_sched_barrier(0);
#pragma unroll
        for (int i8 = 0; i8 < 4; ++i8) { const int ii = 4 * hf + i8, i = 16 * i0 + ii; const f32x2 csn = rc[i8];
            const float q1 = bf2f(r1[i8]), q2 = bf2f(r2[i8]), k1 = bf2f(r3[i8]), k2 = bf2f(r4[i8]);
            const float rq0 = q1 * csn.x - q2 * csn.y, rq1 = q1 * csn.y + q2 * csn.x, rk0 = k1 * csn.x - k2 * csn.y, rk1 = k1 * csn.y + k2 * csn.x;
            QR[i * 264 + d] = f2bf(rq0); QR[i * 264 + 128 + d] = f2bf(rq1); KR[i * 264 + d] = f2bf(rk0); KR[i * 264 + 128 + d] = f2bf(rk1);
            const float gq = __expf((float)(i + 1) * lg), gk = __expf((float)(63 - i) * lg);
            ((GAS bf16*)QT)[i * 256 + d] = f2bf(rq0 * gq); ((GAS bf16*)QT)[i * 256 + 128 + d] = f2bf(rq1 * gq); k0v[ii] = rk0 * gk; k1v[ii] = rk1 * gk; }
        __builtin_amdgcn_sched_barrier(0);
    }
    { unsigned w0[8], w1[8];
#pragma unroll
      for (int jj = 0; jj < 8; ++jj) { w0[jj] = cvtpk(k0v[2 * jj], k0v[2 * jj + 1]); w1[jj] = cvtpk(k1v[2 * jj], k1v[2 * jj + 1]); }
      GAS u32x4* dst = (GAS u32x4*)(KT + (size_t)d * 64 + 16 * i0); dst[0] = (u32x4){w0[0], w0[1], w0[2], w0[3]}; dst[1] = (u32x4){w0[4], w0[5], w0[6], w0[7]};
      dst = (GAS u32x4*)(KT + (size_t)(d + 128) * 64 + 16 * i0); dst[0] = (u32x4){w1[0], w1[1], w1[2], w1[3]}; dst[1] = (u32x4){w1[4], w1[5], w1[6], w1[7]}; }
    __syncthreads();
    stage_tile<256>(F.lds + RR_RAWQ, Z + ZV_R + h * 256, t);
    { const int w = F.wave, r = F.lane & 15, q = F.lane >> 4;
#pragma unroll
      for (int tt = 0; tt < 2; ++tt) { const int T = w + 8 * tt, ti = T >> 2, tj = T & 3; f32x4 acc = (f32x4){0.f, 0.f, 0.f, 0.f};
          if (tj <= ti) { const LAS unsigned char* qa = F.lds + RR_Q + (16 * ti + r) * 528 + 16 * q; const LAS unsigned char* kb = F.lds + RR_K + (16 * tj + r) * 528 + 16 * q;
#pragma unroll
              for (int k = 0; k < 8; ++k) acc = __builtin_amdgcn_mfma_f32_16x16x32_bf16(*(const LAS bf16x8*)(kb + 64 * k), *(const LAS bf16x8*)(qa + 64 * k), acc, 0, 0, 0); }
          const int i = 16 * ti + r, j0 = 16 * tj + 4 * q; float pv[4];
#pragma unroll
          for (int jj = 0; jj < 4; ++jj) pv[jj] = (j0 + jj <= i) ? acc[jj] * __expf((float)(i - j0 - jj) * lg) : 0.f;
          u32x2 pw; pw.x = cvtpk(pv[0], pv[1]); pw.y = cvtpk(pv[2], pv[3]);
          *(GAS u32x2*)(Pm + i * 64 + j0) = pw; } }
    __syncthreads();
    write_vT_lds<256>(t, (const LAS unsigned short*)(F.lds + RR_RAWQ), (bf16*)(F.ws + WS_VT) + VT_R + (size_t)ci * 256 * 64, false);
    __syncthreads();
}

template <bool CONSTLAM, bool USEP>
__device__ __forceinline__ void scan_item(Frame& F, const bf16* QT, int QLD, size_t qci, const bf16* KT, size_t kci, const bf16* VT, size_t vci, const bf16* Pm, const float* LAM, float lamc,
                                          bf16* O, int OLD, int ocol, int H, int h, int b) {
    constexpr int DK = 128, QS = DK * 2 + 16, RS = 144;
    constexpr int OFF_Q = 0, OFF_K = OFF_Q + 64 * QS, OFF_V = OFF_K + DK * RS, OFF_P = OFF_V + 128 * RS, OFF_L = OFF_P + 64 * RS;
    LAS unsigned char* lds = F.lds;
    const int t = F.tid, w = F.wave, r = F.lane & 15, q = F.lane >> 4;
    float zs = 0.f; asm volatile("" : "+v"(zs));
    f32x4 S[DK / 16];
#pragma unroll
    for (int i = 0; i < DK / 16; ++i) S[i] = (f32x4){zs, zs, zs, zs};
    f32x4 rlA = (f32x4){zs, zs, zs, zs}, rlB = rlA; u32x4 rqA[2], rkA[2], rvA[2], rqB[2], rkB[2], rvB[2], rpA = __builtin_bit_cast(u32x4, rlA), rpB = rpA;
    const unsigned qob0 = (unsigned)((t >> 4) * QLD + (t & 15) * 8) * 2u, qob1 = (unsigned)(((t + 512) >> 4) * QLD + (t & 15) * 8) * 2u, lob = (unsigned)t * 16u;
#define SCAN_LOAD(cc, rq, rk, rv, rp, rl) do { \
        const size_t ci_ = (size_t)(b * NCH + (cc)) * H + h; \
        const char* gq_ = (const char*)(QT + ci_ * qci); const char* gk_ = (const char*)(KT + ci_ * kci); const char* gv_ = (const char*)(VT + ci_ * vci); \
        rq[0] = *(const GAS u32x4*)(gq_ + qob0); rq[1] = *(const GAS u32x4*)(gq_ + qob1); \
        rk[0] = *(const GAS u32x4*)(gk_ + lob); rk[1] = *(const GAS u32x4*)(gk_ + lob + 8192u); \
        rv[0] = *(const GAS u32x4*)(gv_ + lob); rv[1] = *(const GAS u32x4*)(gv_ + lob + 8192u); \
        if (USEP) rp = *(const GAS u32x4*)((const char*)(Pm + ci_ * 4096) + lob); \
        if (!CONSTLAM) { if (t < DK / 4) rl = *(const GAS f32x4*)((const char*)(LAM + ci_ * DK) + lob); } \
    } while (0)
#define SCAN_PUT(base, rq, rk, rv, rp, rl) do { \
        _Pragma("unroll") for (int i_ = 0; i_ < 2; ++i_) { const int idx_ = t + 512 * i_; \
            *(LAS u32x4*)((base) + OFF_Q + (idx_ >> 4) * QS + (idx_ & 15) * 16) = rq[i_]; \
            *(LAS u32x4*)((base) + OFF_K + (idx_ >> 3) * RS + (idx_ & 7) * 16) = rk[i_]; \
            *(LAS u32x4*)((base) + OFF_V + (idx_ >> 3) * RS + (idx_ & 7) * 16) = rv[i_]; } \
        if (USEP) *(LAS u32x4*)((base) + OFF_P + (t >> 3) * RS + (t & 7) * 16) = rp; \
        if (!CONSTLAM) { if (t < DK / 4) *(LAS f32x4*)((base) + OFF_L + t * 16) = rl; } \
    } while (0)
    constexpr int BUFB = 65536;
    SCAN_LOAD(0, rqA, rkA, rvA, rpA, rlA);
    SCAN_LOAD(1, rqB, rkB, rvB, rpB, rlB);
    SCAN_PUT(lds, rqA, rkA, rvA, rpA, rlA);
    SCAN_LOAD(2, rqA, rkA, rvA, rpA, rlA);
    __syncthreads();
    for (int c2 = 0; c2 < NCH; c2 += 2) {
#pragma unroll
      for (int ph_ = 0; ph_ < 2; ++ph_) {
        const int c = c2 + ph_;
        if (c < NCH) {
        LAS unsigned char* const ldc = lds + ph_ * BUFB;
        bf16x8 vf[2];
#pragma unroll
        for (int jt = 0; jt < 2; ++jt) vf[jt] = *(const LAS bf16x8*)(ldc + OFF_V + (16 * w + r) * RS + (32 * jt + 8 * q) * 2);
        f32x4 o[4];
#pragma unroll
        for (int it = 0; it < 4; ++it) o[it] = (f32x4){0.f, 0.f, 0.f, 0.f};
#pragma unroll
        for (int kb = 0; kb < 2; ++kb) {
            u32x2 qlo[2][4], qhi[2][4];
#pragma unroll
            for (int k2 = 0; k2 < 2; ++k2)
#pragma unroll
                for (int it = 0; it < 4; ++it) { const int k = 2 * kb + k2; qlo[k2][it] = *(const LAS u32x2*)(ldc + OFF_Q + (16 * it + r) * QS + (32 * k + 4 * q) * 2); qhi[k2][it] = *(const LAS u32x2*)(ldc + OFF_Q + (16 * it + r) * QS + (32 * k + 16 + 4 * q) * 2); }
            bf16x8 sf[2];
#pragma unroll
            for (int k2 = 0; k2 < 2; ++k2) { const int k = 2 * kb + k2; u32x4 p; p.x = cvtpk(S[2 * k][0], S[2 * k][1]); p.y = cvtpk(S[2 * k][2], S[2 * k][3]); p.z = cvtpk(S[2 * k + 1][0], S[2 * k + 1][1]); p.w = cvtpk(S[2 * k + 1][2], S[2 * k + 1][3]); sf[k2] = __builtin_bit_cast(bf16x8, p); }
            __builtin_amdgcn_sched_barrier(0); __builtin_amdgcn_s_setprio(1);
#pragma unroll
            for (int k2 = 0; k2 < 2; ++k2)
#pragma unroll
                for (int it = 0; it < 4; ++it) o[it] = __builtin_amdgcn_mfma_f32_16x16x32_bf16(sf[k2], __builtin_bit_cast(bf16x8, ((u32x4){qlo[k2][it].x, qlo[k2][it].y, qhi[k2][it].x, qhi[k2][it].y})), o[it], 0, 0, 0);
            __builtin_amdgcn_s_setprio(0); __builtin_amdgcn_sched_barrier(0);
        }
        bf16* orow = O + (size_t)(b * LP + c * 64 + r) * OLD + ocol + 16 * w + 4 * q;
        if (USEP) {
            bf16x8 pf[4][2];
#pragma unroll
            for (int it = 0; it < 4; ++it)
#pragma unroll
                for (int jt = 0; jt < 2; ++jt) pf[it][jt] = *(const LAS bf16x8*)(ldc + OFF_P + (16 * it + r) * RS + (32 * jt + 8 * q) * 2);
            __builtin_amdgcn_sched_barrier(0);
#pragma unroll
            for (int jt = 0; jt < 2; ++jt)
#pragma unroll
                for (int it = 0; it < 4; ++it) o[it] = __builtin_amdgcn_mfma_f32_16x16x32_bf16(vf[jt], pf[it][jt], o[it], 0, 0, 0);
        }
#pragma unroll
        for (int it = 0; it < 4; ++it) { u32x2 pw; pw.x = cvtpk(o[it][0], o[it][1]); pw.y = cvtpk(o[it][2], o[it][3]); *(GAS u32x2*)(orow + (size_t)(16 * it) * OLD) = pw; }
        __builtin_amdgcn_sched_barrier(0);
#pragma unroll
        for (int hb = 0; hb < 2; ++hb) {
            bf16x8 kf[4][2];
#pragma unroll
            for (int d4 = 0; d4 < 4; ++d4)
#pragma unroll
                for (int jt = 0; jt < 2; ++jt) kf[d4][jt] = *(const LAS bf16x8*)(ldc + OFF_K + (16 * (4 * hb + d4) + r) * RS + (32 * jt + 8 * q) * 2);
            f32x4 lam[4];
#pragma unroll
            for (int d4 = 0; d4 < 4; ++d4) { if (CONSTLAM) lam[d4] = (f32x4){lamc, lamc, lamc, lamc}; else lam[d4] = *(const LAS f32x4*)(ldc + OFF_L + (16 * (4 * hb + d4) + 4 * q) * 4); }
            __builtin_amdgcn_sched_barrier(0); __builtin_amdgcn_s_setprio(1);
#pragma unroll
            for (int d4 = 0; d4 < 4; ++d4) S[4 * hb + d4] = S[4 * hb + d4] * lam[d4];
#pragma unroll
            for (int jt = 0; jt < 2; ++jt)
#pragma unroll
                for (int d4 = 0; d4 < 4; ++d4) S[4 * hb + d4] = __builtin_amdgcn_mfma_f32_16x16x32_bf16(kf[d4][jt], vf[jt], S[4 * hb + d4], 0, 0, 0);
            __builtin_amdgcn_s_setprio(0); __builtin_amdgcn_sched_barrier(0);
        }
        if (c + 1 < NCH) {
            if (ph_ == 0) { SCAN_PUT(lds + BUFB, rqB, rkB, rvB, rpB, rlB); if (c + 3 < NCH) SCAN_LOAD(c + 3, rqB, rkB, rvB, rpB, rlB); }
            else { SCAN_PUT(lds, rqA, rkA, rvA, rpA, rlA); if (c + 3 < NCH) SCAN_LOAD(c + 3, rqA, rkA, rvA, rpA, rlA); }
        }
        __syncthreads();
        }
      }
    }
#undef SCAN_PUT
#undef SCAN_LOAD
}

constexpr int N_SCAN_ITEMS = 64;
__device__ __forceinline__ void scan_phase(Frame& F, int L) {
    const bf16* QT = (const bf16*)(F.ws + WS_QT); const bf16* KT = (const bf16*)(F.ws + WS_KT); const bf16* VT = (const bf16*)(F.ws + WS_VT); const bf16* Pm = (const bf16*)(F.ws + WS_P);
    bf16* O = (bf16*)(F.ws + WS_O); bf16* O2 = (bf16*)(F.ws + WS_O2);
    if (F.G > N_SCAN_ITEMS && F.bid >= N_SCAN_ITEMS) {
        const int gw = (F.bid - N_SCAN_ITEMS) * 8 + F.wave, NGW = (F.G - N_SCAN_ITEMS) * 8;
        for (int j = 0; j < (L == 0 ? 2 : 1); ++j) convert_range(F, j == 0 ? L : 1, j == 0 ? CI_PARTA : 0, j == 0 ? CI_ALL : CI_PARTA, gw, NGW);
        return;
    }
    for (int item = F.bid; item < N_SCAN_ITEMS; item += F.G) {
        if (item < 16) { const int es = item & 1, h = (item >> 1) & 3, b = item >> 3;
            scan_item<false, true>(F, QT + QT_G, 128, 64 * 128, KT + QT_G, 128 * 64, VT + VT_G + (size_t)es * 128 * 64, 256 * 64, Pm + P_G, (const float*)(F.ws + WS_LAMG), 0.f, O, 3072, 0 + h * 256 + es * 128, 4, h, b);
        } else if (item < 48) { const int it = item - 16, dh = it & 1, es = (it >> 1) & 1, h = (it >> 2) & 3, b = it >> 4;
            const float lamc = __expf(64.f * logf(1.f - exp2f(-5.f - (float)h)));
            if (dh == 0) scan_item<true, true>(F, QT + QT_R, 256, 64 * 256, KT + QT_R, 256 * 64, VT + VT_R + (size_t)es * 128 * 64, 256 * 64, Pm + P_R, nullptr, lamc, O, 3072, 1024 + h * 256 + es * 128, 4, h, b);
            else scan_item<true, false>(F, QT + QT_R + 128, 256, 64 * 256, KT + QT_R + (size_t)128 * 64, 256 * 64, VT + VT_R + (size_t)es * 128 * 64, 256 * 64, Pm + P_R, nullptr, lamc, O2, 1024, h * 256 + es * 128, 4, h, b);
        } else { const int it = item - 48, h = it & 7, b = it >> 3;
            scan_item<false, true>(F, QT + QT_H, 128, 64 * 128, KT + QT_H, 128 * 64, VT + VT_H, 128 * 64, Pm + P_H, (const float*)(F.ws + WS_LAMH), 0.f, O, 3072, 2048 + h * 128, 8, h, b);
        }
    }
}

__device__ __forceinline__ void normgate_phase(Frame& F, int L) {
    const int gw = F.vcu * 8 + F.wave, NGW = F.G * 8, lane = F.lane;
    const bf16* O = (const bf16*)(F.ws + WS_O); const bf16* O2 = (const bf16*)(F.ws + WS_O2); const bf16* Z = (const bf16*)(F.ws + WS_Z); bf16* YS = (bf16*)(F.ws + WS_YS);
    for (int r = gw; r < MR; r += NGW) {
#pragma unroll
        for (int br = 0; br < 3; ++br) {
            const float* gain = F.in[br == 0 ? 10 : (br == 1 ? 11 : 13)] + (size_t)L * 1024;
            const int zg = br == 0 ? ZG_G : (br == 1 ? ZG_R : ZG_H);
#pragma unroll
            for (int hh = 0; hh < 4; ++hh) { const int col = hh * 256 + 4 * lane;
                const u32x2 pa = *(const GAS u32x2*)(O + (size_t)r * 3072 + br * 1024 + col);
                f32x4 v = (f32x4){bflo(pa.x), bfhi(pa.x), bflo(pa.y), bfhi(pa.y)};
                if (br == 1) { const u32x2 pb = *(const GAS u32x2*)(O2 + (size_t)r * 1024 + col); v = v + (f32x4){bflo(pb.x), bfhi(pb.x), bflo(pb.y), bfhi(pb.y)}; }
                if (br == 1) { const float mean = wave_sum((v[0] + v[1]) + (v[2] + v[3])) * (1.f / 256.f); v = v - mean; }
                float ss = (v[0] * v[0] + v[1] * v[1]) + (v[2] * v[2] + v[3] * v[3]);
                if (br == 2) {
#pragma unroll
                    for (int o = 1; o < 32; o <<= 1) ss += __shfl_xor(ss, o);
                    ss *= (1.f / 128.f);
                } else ss = wave_sum(ss) * (1.f / 256.f);
                const float rs = __builtin_amdgcn_rsqf(ss + EPS);
                const f32x4 gn = *(const GAS f32x4*)(gain + col); const u32x2 gz = *(const GAS u32x2*)(Z + (size_t)r * NIN + zg + col);
                const float y0 = v[0] * rs * gn[0] * silu_f(bflo(gz.x)), y1 = v[1] * rs * gn[1] * silu_f(bfhi(gz.x)), y2 = v[2] * rs * gn[2] * silu_f(bflo(gz.y)), y3 = v[3] * rs * gn[3] * silu_f(bfhi(gz.y));
                u32x2 w; w.x = cvtpk(y0, y1); w.y = cvtpk(y2, y3); *(GAS u32x2*)(YS + (size_t)r * 3072 + br * 1024 + col) = w; }
        }
    }
}

__device__ __forceinline__ void final_phase(Frame& F, float* out) {
    const int gw = F.vcu * 8 + F.wave, NGW = F.G * 8, lane = F.lane;
    const float* H = (const float*)(F.ws + WS_H); const u64* ssq = (const u64*)(F.ws + WS_SSQ) + (size_t)6 * MP; const float* gain = F.in[20];
    for (int o = gw; o < NBATCH * SEQ; o += NGW) { const int b = o / SEQ, s = o % SEQ, r = b * LP + 64 + s; const float rs = __builtin_amdgcn_rsqf(ssq_get(ssq, r) * (1.f / D) + EPS);
#pragma unroll
        for (int j = 0; j < 8; ++j) { const f32x4 v = ((const GAS f32x4*)(H + (size_t)r * D))[lane + 64 * j], gn = ((const GAS f32x4*)gain)[lane + 64 * j]; ((GAS f32x4*)(out + (size_t)o * D))[lane + 64 * j] = v * rs * gn; } }
}

#define XB_TMO      128
#define XB_XCNT(j)  (256  + 64 * (j))
#define XB_XSUB(j)  (1280 + 64 * (j))
#define XB_XGEN(j)  (2304 + 64 * (j))
#define XB_TOP      3328
#define XB_TOPGEN   3392
#define XCD_BAR_WORDS 3456
#define XB_SPIN_CAP (1u << 18)

__device__ __forceinline__ unsigned xb_ld(unsigned* p)              { return __hip_atomic_load(p, __ATOMIC_RELAXED, __HIP_MEMORY_SCOPE_AGENT); }
__device__ __forceinline__ unsigned xb_add(unsigned* p, unsigned v) { return __hip_atomic_fetch_add(p, v, __ATOMIC_RELAXED, __HIP_MEMORY_SCOPE_AGENT); }
__device__ __forceinline__ unsigned xb_xcc_id() { return (unsigned)__builtin_amdgcn_s_getreg((3 << 11) | 20) & 0xFu; }
#define XB_SPIN(cond, bar) do { unsigned _sp = 0; while (cond) { __builtin_amdgcn_s_sleep(1); \
    if ((++_sp & 255u) == 0u) { if (xb_ld(&(bar)[XB_TMO])) break; if (_sp > XB_SPIN_CAP) { atomicAdd(&(bar)[XB_TMO], 1u); break; } } } } while (0)

struct XcdBarrier {
    unsigned* bar; unsigned x;
    volatile LAS unsigned* st;
};

__device__ __forceinline__ XcdBarrier xcd_barrier_post(unsigned* bar, volatile LAS unsigned* st) {
    XcdBarrier b; b.bar = bar; b.x = xb_xcc_id(); b.st = st;
    if (threadIdx.x == 0) (void)xb_add(&bar[XB_XCNT(b.x)], 1u);
    return b;
}
__device__ __forceinline__ void xcd_barrier_complete(unsigned* bar, unsigned x, unsigned& nloc, unsigned& nx) {
    const unsigned G = gridDim.x * gridDim.y * gridDim.z;
    unsigned sum, cnt, mine, sp = 0u;
    for (;;) {
        sum = 0u; cnt = 0u; mine = 0u;
#pragma unroll
        for (unsigned j = 0; j < 16; ++j) { const unsigned c = xb_ld(&bar[XB_XCNT(j)]); sum += c; cnt += (c > 0u) ? 1u : 0u; mine = (j == x) ? c : mine; }
        if (sum == G) break;
        __builtin_amdgcn_s_sleep(1);
        if ((++sp & 255u) == 0u) { if (xb_ld(&bar[XB_TMO])) break; if (sp > XB_SPIN_CAP) { atomicAdd(&bar[XB_TMO], 1u); break; } }
    }
    nloc = mine > 0u ? mine : 1u; nx = cnt > 0u ? cnt : 1u;
}

__device__ __forceinline__ void xcd_barrier(const XcdBarrier& b) {
    asm volatile("s_waitcnt vmcnt(0)" ::: "memory");
    __syncthreads();
    if (threadIdx.x == 0) {
        unsigned* bar = b.bar;
        __builtin_amdgcn_s_waitcnt(0);
        unsigned nloc = b.st[0], nx = b.st[1];
        if (nloc == 0u) { xcd_barrier_complete(bar, b.x, nloc, nx); b.st[0] = nloc; b.st[1] = nx; }
        const unsigned old = xb_add(&bar[XB_XSUB(b.x)], 1u);
        const unsigned gen = old / nloc;
        if (old + 1u == (gen + 1u) * nloc) {
            __builtin_amdgcn_fence(__ATOMIC_RELEASE, "agent");
            asm volatile("s_waitcnt vmcnt(0)" ::: "memory");
            const unsigned og = xb_add(&bar[XB_TOP], 1u);
            const unsigned tg = og / nx;
            if (og + 1u == (tg + 1u) * nx) xb_add(&bar[XB_TOPGEN], 1u);
            else XB_SPIN(xb_ld(&bar[XB_TOPGEN]) == tg, bar);
            __builtin_amdgcn_fence(__ATOMIC_ACQUIRE, "agent");
            xb_add(&bar[XB_XGEN(b.x)], 1u);
            asm volatile("s_waitcnt vmcnt(0)" ::: "memory");
        } else {
            XB_SPIN(xb_ld(&bar[XB_XGEN(b.x)]) == gen, bar);
            __builtin_amdgcn_fence(__ATOMIC_ACQUIRE, "agent");
            asm volatile("s_waitcnt vmcnt(0)" ::: "memory");
        }
    }
    __syncthreads();
}


__global__ void __launch_bounds__(512, 2) trunk_fwd(Args args) {
    extern __shared__ __attribute__((aligned(16))) unsigned char lds_raw[];
    Frame F;
    F.lds = (LAS unsigned char*)lds_raw;
    if (threadIdx.x == 0) { volatile LAS unsigned* st_ = (volatile LAS unsigned*)((LAS unsigned char*)lds_raw + 147328); st_[0] = 0u; st_[1] = 0u; }
    if (args.ph_hi - args.ph_lo > 1) {
        if (blockIdx.x == 0) { for (int i_ = threadIdx.x; i_ < XCD_BAR_WORDS; i_ += 512) ((unsigned*)(args.ws + WS_BAR))[i_] = 0u; }
        __syncthreads(); cg::this_grid().sync();
        (void)xcd_barrier_post((unsigned*)(args.ws + WS_BAR), (volatile LAS unsigned*)((LAS unsigned char*)lds_raw + 147328));
    }
#if REPEAT_KIND >= 0
    for (int ph2 = 2 * args.ph_lo; ph2 < 2 * args.ph_hi; ++ph2) {
        const int ph = ph2 >> 1;
        { int k_ = ph == 0 ? 0 : (ph <= 10 ? ph : (ph <= 20 ? ph - 10 : 12));
          const bool rpt = (k_ == REPEAT_KIND) || (REPEAT_KIND == 1 && k_ == 9) || (REPEAT_KIND == 0 && k_ == 11);
          if ((ph2 & 1) && !rpt) continue; }
#else
    for (int ph = args.ph_lo; ph < args.ph_hi; ++ph) {
#endif
        unsigned char* ws = args.ws; asm volatile("" : "+s"(ws));
        int tid_ = threadIdx.x; asm volatile("" : "+v"(tid_));
        int bid = blockIdx.x; asm volatile("" : "+s"(bid));
        int G_ = gridDim.x; asm volatile("" : "+s"(G_)); F.G = G_;
        int zero_ = 0; asm volatile("" : "+s"(zero_)); F.in = args.in + zero_;
        F.ws = ws; F.tid = tid_; F.lane = tid_ & 63; F.wave = __builtin_amdgcn_readfirstlane(tid_ >> 6); F.bid = bid;
        F.vcu = (F.G % 8 == 0) ? (bid % 8) * (F.G / 8) + bid / 8 : bid;
        u64* ssq = (u64*)(ws + WS_SSQ);
        bf16* HB = (bf16*)(ws + WS_HB); float* Hf = (float*)(ws + WS_H); bf16* Zb = (bf16*)(ws + WS_Z); bf16* ACT = Zb;
        int L = 0, kind;
        if (ph == 0) kind = 0; else if (ph <= 10) kind = ph; else if (ph <= 20) { kind = ph - 10; L = 1; } else kind = 12;
        if (kind == 0) { if (KEN(0)) { init_phase(F); convert_range(F, 0, 0, CI_PARTA, F.vcu * 8 + F.wave, F.G * 8); } }
        else if (KEN(1) && (kind == 1 || kind == 9)) {
            pg8::Gemm g{HB, (const bf16*)(ws + WS_W + (kind == 1 ? W_GU1 : W_GU2)), D, D, D, 0, 0, 1, 0}; { pg8::MainRounds S; S.init(8192, NGU, F.G, F.bid, D);
              pg8::EpiGateUpT<false> E{ACT, ssq + (size_t)(3 * L + (kind == 1 ? 0 : 2)) * MP};
              pg8::gemm_phase<pg8::EpiGateUpT<false>, pg8::MainRounds>(F.lds, g, S, E, F.tid); }
            { pg8::TailHalves S; S.init(8192, NGU, F.G, F.bid, D);
              pg8::EpiGateUpT<true> E{ACT, ssq + (size_t)(3 * L + (kind == 1 ? 0 : 2)) * MP};
              pg8::gemm_phase<pg8::EpiGateUpT<true>, pg8::TailHalves>(F.lds, g, S, E, F.tid); }
        } else if (KEN(2) && (kind == 2 || kind == 10)) {
            const bf16* Wd = (const bf16*)(ws + WS_W + (kind == 2 ? W_D1 : W_D2)); const int si = 3 * L + (kind == 2 ? 1 : 3);
            { pg8::Gemm g{ACT, Wd, FF, FF, FF, 512, 512, 1 << 30, 0}; pg8::SplitOrder S; S.init(32, D, FF, 1, F.G, F.bid);
              pg8::EpiSplitStore E{ws, ph * 8};
              pg8::gemm_phase<pg8::EpiSplitStore, pg8::SplitOrder>(F.lds, g, S, E, F.tid); }
            { pg8::Gemm g{ACT, Wd, FF, FF, FF, 0, 0, 1, 0}; pg8::StaticOrder S; S.init(8192, D, F.G, F.bid, 1, FF);
              pg8::EpiResid E{(L == 1 && kind == 10) ? Hf : nullptr, HB, ssq + (size_t)si * MP, 0.5f};
              pg8::gemm_phase<pg8::EpiResid, pg8::StaticOrder>(F.lds, g, S, E, F.tid); }
            pg8::split_finish_resid(ws, si, 0.5f, ph * 8, FF / 256, 32, F.bid, F.tid, L == 1 && kind == 10);
        } else if (KEN(3) && kind == 3) {
            pg8::Gemm g{HB, (const bf16*)(ws + WS_W + W_IN), D, D, D, 0, 0, 1, 0}; pg8::StaticOrder S; S.init(MP, NIN, F.G, F.bid, 1, D);
            pg8::EpiRowScale E{Zb, NIN, ssq + (size_t)(3 * L + 1) * MP};
            pg8::gemm_phase<pg8::EpiRowScale, pg8::StaticOrder>(F.lds, g, S, E, F.tid);
        } else if (KEN(4) && kind == 4) {
            for (int it = F.bid; it < 2080; it += F.G) { if (it < 520) prep_gh<0>(F, L, it); else if (it < 1040) prep_ret(F, it - 520); else prep_gh<2>(F, L, it - 1040); }
        } else if (KEN(5) && kind == 5) { scan_phase(F, L); }
        else if (KEN(6) && kind == 6) { normgate_phase(F, L); }
        else if (KEN(7) && kind == 7) {
            { pg8::Gemm g{(const bf16*)(ws + WS_YS), (const bf16*)(ws + WS_W + W_B), 3072, 1024, 1024, 512, 512, 4, (size_t)D * 1024 * 2}; pg8::SplitOrder S; S.init(32, D, 1024, 3, F.G, F.bid);
              pg8::EpiSplitStore E{ws, ph * 8};
              pg8::gemm_phase<pg8::EpiSplitStore, pg8::SplitOrder>(F.lds, g, S, E, F.tid); }
            { pg8::Gemm g{(const bf16*)(ws + WS_YS), (const bf16*)(ws + WS_W + W_B), 3072, 1024, 1024, (size_t)1024 * 2, 0, 1, (size_t)D * 1024 * 2}; pg8::StaticOrder S; S.init(8192, D, F.G, F.bid, 3, 1024);
              pg8::EpiBranch E{Zb, (bf16*)(ws + WS_MB)};
              pg8::gemm_phase<pg8::EpiBranch, pg8::StaticOrder>(F.lds, g, S, E, F.tid); }
            pg8::split_finish_branch(ws, ph * 8, 4, 32, F.bid, F.tid);
        } else if (KEN(8) && kind == 8) {
            { pg8::Gemm g{(const bf16*)(ws + WS_MB), (const bf16*)(ws + WS_W + W_O), D, D, D, 512, 512, 1 << 30, 0}; pg8::SplitOrder S; S.init(32, D, D, 1, F.G, F.bid);
              pg8::EpiSplitStore E{ws, ph * 8};
              pg8::gemm_phase<pg8::EpiSplitStore, pg8::SplitOrder>(F.lds, g, S, E, F.tid); }
            { pg8::Gemm g{(const bf16*)(ws + WS_MB), (const bf16*)(ws + WS_W + W_O), D, D, D, 0, 0, 1, 0}; pg8::StaticOrder S; S.init(8192, D, F.G, F.bid, 1, D);
              pg8::EpiResid E{nullptr, HB, ssq + (size_t)(3 * L + 2) * MP, 1.0f};
              pg8::gemm_phase<pg8::EpiResid, pg8::StaticOrder>(F.lds, g, S, E, F.tid); }
            pg8::split_finish_resid(ws, 3 * L + 2, 1.0f, ph * 8, D / 256, 32, F.bid, F.tid, false);
        } else if (KEN(12) && kind == 12) { final_phase(F, args.out); }
        if (ph + 1 < args.ph_hi) {
            volatile LAS unsigned* st_ = (volatile LAS unsigned*)((LAS unsigned char*)lds_raw + 147328);
            { XcdBarrier xb_; xb_.bar = (unsigned*)(ws + WS_BAR); xb_.x = xb_xcc_id(); xb_.st = st_; xcd_barrier(xb_); }
        }
    }
}

extern "C" void kernel_launch(void* const* d_in, const int* in_sizes, int n_in, void* d_out, int out_size, void* d_ws, size_t ws_size, hipStream_t stream) {
    static int grid = 0;
    if (grid == 0) {
        if (n_in != 21 || out_size != NBATCH * SEQ * D || ws_size < WS_END) { fprintf(stderr, "kernel_launch: unexpected shapes (n_in %d out %d ws %zu need %zu)\n", n_in, out_size, ws_size, (size_t)WS_END); grid = -1; return; }
        int dev = 0, cus = 0;
        if (hipGetDevice(&dev) != hipSuccess || hipDeviceGetAttribute(&cus, hipDeviceAttributeMultiprocessorCount, dev) != hipSuccess) { grid = -1; return; }
        if (hipFuncSetAttribute((const void*)trunk_fwd, hipFuncAttributeMaxDynamicSharedMemorySize, LDS_BYTES) != hipSuccess) { fprintf(stderr, "kernel_launch: hipFuncSetAttribute failed\n"); grid = -1; return; }
        int per_cu = 0;
        if (hipOccupancyMaxActiveBlocksPerMultiprocessor(&per_cu, (const void*)trunk_fwd, 512, LDS_BYTES) != hipSuccess || per_cu < 1) { fprintf(stderr, "kernel_launch: occupancy query says %d\n", per_cu); }
        (void)hipGetLastError();
        grid = cus;
    }
    if (grid < 0) return;
    Args a{};
    for (int i = 0; i < 21; ++i) a.in[i] = (const float*)d_in[i];
    a.out = (float*)d_out; a.ws = (unsigned char*)d_ws;
#if ONE_LAUNCH
    a.ph_lo = 0; a.ph_hi = NPHASE;
    void* kargs[] = {&a};
    hipError_t e = hipLaunchCooperativeKernel((const void*)trunk_fwd, dim3(grid), dim3(512), kargs, LDS_BYTES, stream);
    if (e != hipSuccess) fprintf(stderr, "cooperative launch failed: %s (grid %d)\n", hipGetErrorString(e), grid);
#else
    for (int ph = 0; ph < NPHASE; ++ph) { a.ph_lo = ph; a.ph_hi = ph + 1; hipLaunchKernelGGL(trunk_fwd, dim3(grid), dim3(512), LDS_BYTES, stream, a); }
#endif
}
```
